# Optimizing an MI355X kernel written in HIP

```python
import jax, jax.numpy as jnp
from jax import lax
import numpy as np

D_MODEL = 1024
BATCH = 2
SEQ = 16384
DEPTH = 2

SB_HEADS = 8
SB_HEAD_DIM = 64
SB_BLOCK = 128
SW_Q_HEADS = 8
SW_KV_HEADS = 2
SW_HEAD_DIM = 64
SW_WINDOW = 128
SW_BLOCK = 128
GDN_HEADS = 4
GDN_HEAD_DIM = 128
GDN_CONV = 4
GDN_CHUNK = 64
D_FF = 2816
FFN_CONV = 3
NORM_EPS = 1e-6

SB_WIDTH = SB_HEADS * SB_HEAD_DIM
SW_Q_WIDTH = SW_Q_HEADS * SW_HEAD_DIM
SW_KV_WIDTH = SW_KV_HEADS * SW_HEAD_DIM
GDN_WIDTH = GDN_HEADS * GDN_HEAD_DIM
IN_SPLITS = (SB_WIDTH, SB_WIDTH, SB_WIDTH,
             SW_Q_WIDTH, SW_KV_WIDTH, SW_KV_WIDTH,
             3 * GDN_WIDTH, GDN_WIDTH, GDN_HEADS, GDN_HEADS,
             D_MODEL, D_MODEL, D_MODEL)
IN_COLS = sum(IN_SPLITS)

kernel_name = 'hybrid_sb_swa_gdn_convffn'


def rms_norm(t, gain):
    t32 = t.astype(jnp.float32)
    y = t32 * lax.rsqrt(jnp.mean(t32 * t32, axis=-1, keepdims=True) + NORM_EPS)
    return (y * gain.astype(jnp.float32)).astype(t.dtype)


def l2_norm(t):
    return t * lax.rsqrt(jnp.sum(t * t, axis=-1, keepdims=True) + NORM_EPS)


def split_columns(t, sizes):
    out = []
    start = 0
    for s in sizes:
        out.append(t[..., start:start + s])
        start += s
    return out


def causal_dwconv(t, w):
    k_width = w.shape[0]
    seq = t.shape[1]
    tp = jnp.pad(t, ((0, 0), (k_width - 1, 0), (0, 0)))
    y = w[0] * tp[:, 0:seq]
    for k in range(1, k_width):
        y = y + w[k] * tp[:, k:k + seq]
    return y


def stick_breaking_attention(q, k, v):
    b, s, h, d = q.shape
    n = s // SB_BLOCK
    scale = d ** -0.5

    def blocks(t):
        return t.astype(jnp.float32).reshape(b, n, SB_BLOCK, h, d).transpose(1, 0, 3, 2, 4)

    qb, kb, vb = blocks(q), blocks(k), blocks(v)
    local = jnp.arange(SB_BLOCK)

    def query_block(i):
        qi = qb[i]
        q_pos = i * SB_BLOCK + local

        def key_step(m, carry):
            acc, log_rem = carry
            j = i - m
            kj = lax.dynamic_index_in_dim(kb, j, 0, keepdims=False)
            vj = lax.dynamic_index_in_dim(vb, j, 0, keepdims=False)
            z = jnp.einsum('bhqd,bhkd->bhqk', qi, kj) * scale
            valid = (j * SB_BLOCK + local)[None, :] < q_pos[:, None]
            log_stay = jnp.where(valid, jax.nn.log_sigmoid(-z), 0.0)
            later = lax.cumsum(log_stay, axis=3, reverse=True) - log_stay
            w = jnp.where(valid, jnp.exp(jax.nn.log_sigmoid(z) + later + log_rem[..., None]), 0.0)
            acc = acc + jnp.einsum('bhqk,bhkd->bhqd', w, vj)
            log_rem = log_rem + jnp.sum(log_stay, axis=-1)
            return acc, log_rem

        init = (jnp.zeros((b, h, SB_BLOCK, d), jnp.float32), jnp.zeros((b, h, SB_BLOCK), jnp.float32))
        acc, _ = lax.fori_loop(0, i + 1, key_step, init)
        return acc

    out = lax.map(query_block, jnp.arange(n))
    return out.transpose(1, 0, 3, 2, 4).reshape(b, s, h * d)


def sliding_window_attention(q, k, v, sinks):
    b, s, _, d = q.shape
    n = s // SW_BLOCK
    g = SW_Q_HEADS // SW_KV_HEADS
    qb = q.reshape(b, n, SW_BLOCK, SW_KV_HEADS, g, d)

    def band(t):
        tb = t.reshape(b, n, SW_BLOCK, SW_KV_HEADS, d)
        prev = jnp.pad(tb, ((0, 0), (1, 0), (0, 0), (0, 0), (0, 0)))[:, :-1]
        return jnp.concatenate([prev, tb], axis=2)

    kb, vb = band(k), band(v)
    scores = jnp.einsum('bnqhgd,bnshd->bnhgqs', qb, kb,
                        preferred_element_type=jnp.float32) * (d ** -0.5)
    qi = jnp.arange(SW_BLOCK)[:, None] + SW_BLOCK
    si = jnp.arange(2 * SW_BLOCK)[None, :]
    dist = qi - si
    key_pos = jnp.arange(n)[:, None] * SW_BLOCK - SW_BLOCK + si
    valid = ((dist >= 0) & (dist < SW_WINDOW))[None] & (key_pos >= 0)[:, None, :]
    slopes = jnp.exp2(-8.0 * jnp.arange(1, SW_Q_HEADS + 1, dtype=jnp.float32) / SW_Q_HEADS)
    slopes = slopes.reshape(SW_KV_HEADS, g, 1, 1)
    scores = scores - slopes * dist.astype(jnp.float32)
    scores = jnp.where(valid[None, :, None, None], scores, -jnp.inf)
    sink = jnp.broadcast_to(sinks.astype(jnp.float32).reshape(SW_KV_HEADS, g, 1, 1), scores.shape[:-1] + (1,))
    p = jax.nn.softmax(jnp.concatenate([scores, sink], axis=-1), axis=-1)[..., :-1]
    o = jnp.einsum('bnhgqs,bnshd->bnqhgd', p.astype(v.dtype), vb)
    return o.reshape(b, s, SW_Q_HEADS * d)


def gated_delta_rule(q, k, v, g, beta):
    b, s, h, dk = q.shape
    dv = v.shape[-1]
    c = GDN_CHUNK
    n = s // c

    def chunks(t):
        return t.reshape(b, n, c, h, t.shape[-1]).transpose(1, 0, 3, 2, 4)

    q = chunks(q * (dk ** -0.5))
    k = chunks(k)
    v = chunks(v)
    g = g.reshape(b, n, c, h).transpose(1, 0, 3, 2)
    beta = beta.reshape(b, n, c, h).transpose(1, 0, 3, 2)
    gc = jnp.cumsum(g, axis=-1)
    idx = jnp.arange(c)
    causal = idx[:, None] >= idx[None, :]
    strict = idx[:, None] > idx[None, :]
    decay = jnp.exp(jnp.where(causal, gc[..., :, None] - gc[..., None, :], -jnp.inf))
    k_beta = k * beta[..., None]
    lower = jnp.where(strict, jnp.einsum('nbhid,nbhjd->nbhij', k_beta, k) * decay, 0.0)
    eye = jnp.eye(c, dtype=jnp.float32)
    t_inv = lax.linalg.triangular_solve(lower + eye, jnp.broadcast_to(eye, lower.shape),
                                        left_side=True, lower=True, unit_diagonal=True)
    u = t_inv @ (v * beta[..., None])
    w = t_inv @ (k_beta * jnp.exp(gc)[..., None])
    a_intra = jnp.where(causal, jnp.einsum('nbhid,nbhjd->nbhij', q, k) * decay, 0.0)
    q_dec = q * jnp.exp(gc)[..., None]
    k_dec = k * jnp.exp(gc[..., -1:] - gc)[..., None]
    g_last = jnp.exp(gc[..., -1])

    def step(state, xs):
        u_i, w_i, q_i, k_i, a_i, gl = xs
        v_new = u_i - w_i @ state
        o = q_i @ state + a_i @ v_new
        state = state * gl[..., None, None] + jnp.swapaxes(k_i, -1, -2) @ v_new
        return state, o

    state0 = jnp.zeros((b, h, dk, dv), jnp.float32)
    _, o = lax.scan(step, state0, (u, w, q_dec, k_dec, a_intra, g_last))
    return o.transpose(1, 0, 3, 2, 4).reshape(b, s, h, dv)


def setup_inputs(seed: int = 0) -> dict:
    key = jax.random.key(seed)
    ks = jax.random.split(key, 20)
    f32 = jnp.float32

    def gain(k, width):
        return 1.0 + 0.05 * jax.random.normal(k, (DEPTH, width), f32)

    dt = jnp.exp(jax.random.uniform(ks[6], (DEPTH, GDN_HEADS), f32, np.log(1e-3), np.log(1e-1)))
    return {
        'x': jax.random.normal(ks[0], (BATCH, SEQ, D_MODEL), f32),
        'ln_mix_pre': gain(ks[1], D_MODEL),
        'w_in': jax.random.normal(ks[2], (DEPTH, D_MODEL, IN_COLS), f32) * D_MODEL ** -0.5,
        'sw_sinks': 0.5 * jax.random.normal(ks[3], (DEPTH, SW_Q_HEADS), f32),
        'gdn_conv': jax.random.normal(ks[4], (DEPTH, GDN_CONV, 3 * GDN_WIDTH), f32) * GDN_CONV ** -0.5,
        'gdn_a_log': jnp.log(jax.random.uniform(ks[5], (DEPTH, GDN_HEADS), f32, 1.0, 16.0)),
        'gdn_dt_bias': jnp.log(jnp.expm1(dt)),
        'gdn_norm': gain(ks[7], GDN_HEAD_DIM),
        'w_branch_a': jax.random.normal(ks[8], (DEPTH, SB_WIDTH, D_MODEL), f32) * SB_WIDTH ** -0.5,
        'w_branch_b': jax.random.normal(ks[9], (DEPTH, SW_Q_WIDTH, D_MODEL), f32) * SW_Q_WIDTH ** -0.5,
        'w_branch_c': jax.random.normal(ks[10], (DEPTH, GDN_WIDTH, D_MODEL), f32) * GDN_WIDTH ** -0.5,
        'w_out': jax.random.normal(ks[11], (DEPTH, D_MODEL, D_MODEL), f32) * D_MODEL ** -0.5,
        'ln_mix_post': gain(ks[12], D_MODEL),
        'ln_ffn_pre': gain(ks[13], D_MODEL),
        'w_up': jax.random.normal(ks[14], (DEPTH, D_MODEL, 2 * D_FF), f32) * D_MODEL ** -0.5,
        'ffn_conv': jax.random.normal(ks[15], (DEPTH, FFN_CONV, 2 * D_FF), f32) * FFN_CONV ** -0.5,
        'w_down': jax.random.normal(ks[16], (DEPTH, D_FF, D_MODEL), f32) * D_FF ** -0.5,
        'ln_ffn_post': gain(ks[17], D_MODEL),
    }


def reference(x, ln_mix_pre, w_in, sw_sinks, gdn_conv, gdn_a_log, gdn_dt_bias, gdn_norm,
              w_branch_a, w_branch_b, w_branch_c, w_out, ln_mix_post, ln_ffn_pre, w_up,
              ffn_conv, w_down, ln_ffn_post):
    b, s, _ = x.shape
    for layer in range(DEPTH):
        h = rms_norm(x, ln_mix_pre[layer])
        proj = h @ w_in[layer]
        (a_q, a_k, a_v, b_q, b_k, b_v, c_qkv, c_z, c_a, c_b,
         gate_a, gate_b, gate_c) = split_columns(proj, IN_SPLITS)

        y_a = stick_breaking_attention(a_q.reshape(b, s, SB_HEADS, SB_HEAD_DIM),
                                       a_k.reshape(b, s, SB_HEADS, SB_HEAD_DIM),
                                       a_v.reshape(b, s, SB_HEADS, SB_HEAD_DIM)).astype(x.dtype)

        y_b = sliding_window_attention(b_q.reshape(b, s, SW_Q_HEADS, SW_HEAD_DIM),
                                       b_k.reshape(b, s, SW_KV_HEADS, SW_HEAD_DIM),
                                       b_v.reshape(b, s, SW_KV_HEADS, SW_HEAD_DIM),
                                       sw_sinks[layer]).astype(x.dtype)

        qkv = jax.nn.silu(causal_dwconv(c_qkv, gdn_conv[layer]))
        c_q, c_k, c_v = split_columns(qkv.astype(jnp.float32), (GDN_WIDTH, GDN_WIDTH, GDN_WIDTH))
        c_q = l2_norm(c_q.reshape(b, s, GDN_HEADS, GDN_HEAD_DIM))
        c_k = l2_norm(c_k.reshape(b, s, GDN_HEADS, GDN_HEAD_DIM))
        c_v = c_v.reshape(b, s, GDN_HEADS, GDN_HEAD_DIM)
        log_decay = -jnp.exp(gdn_a_log[layer].astype(jnp.float32)) * jax.nn.softplus(
            c_a.astype(jnp.float32) + gdn_dt_bias[layer].astype(jnp.float32))
        beta = jax.nn.sigmoid(c_b.astype(jnp.float32))
        o_c = gated_delta_rule(c_q, c_k, c_v, log_decay, beta)
        y_c = (rms_norm(o_c, gdn_norm[layer]) *
               jax.nn.silu(c_z.astype(jnp.float32).reshape(b, s, GDN_HEADS, GDN_HEAD_DIM)))
        y_c = y_c.reshape(b, s, GDN_WIDTH).astype(x.dtype)

        merged = (jax.nn.sigmoid(gate_a) * (y_a @ w_branch_a[layer])
                  + jax.nn.sigmoid(gate_b) * (y_b @ w_branch_b[layer])
                  + jax.nn.sigmoid(gate_c) * (y_c @ w_branch_c[layer]))
        x = x + rms_norm(merged @ w_out[layer], ln_mix_post[layer])

        h = rms_norm(x, ln_ffn_pre[layer])
        hid = causal_dwconv(h @ w_up[layer], ffn_conv[layer])
        f_gate, f_up = hid[..., :D_FF], hid[..., D_FF:]
        f = (jax.nn.gelu(f_gate, approximate=True) * f_up) @ w_down[layer]
        x = x + rms_norm(f, ln_ffn_post[layer])
    return x
```

```cpp
#include <hip/hip_runtime.h>
#include <hip/hip_bf16.h>
#include <hip/hip_cooperative_groups.h>
#include <cstdio>
namespace cg = cooperative_groups;

#ifndef MULTI_LAUNCH
#define MULTI_LAUNCH 1
#endif

typedef unsigned short u16;
using bf16x8 = __attribute__((ext_vector_type(8))) short;
using f32x16 = __attribute__((ext_vector_type(16))) float;

constexpr int SEQ = 16384;
constexpr int NB = 2;
constexpr int TT = NB * SEQ;
constexpr int DM = 1024;
constexpr int INC = 7432;
constexpr int PC = 4352;
constexpr int DFF = 2816;
constexpr int DEPTH = 2;
constexpr int C_AQ = 0, C_AK = 512, C_AV = 1024, C_BQ = 1536, C_BK = 2048, C_BV = 2176, C_CQ = 2304, C_CK = 2816,
              C_CV = 3328, C_CZ = 3840;
constexpr long W_IN = 0;
constexpr long W_GATE = W_IN + 4352L * 1024;
constexpr long W_BR = W_GATE + 3072L * 1024;
constexpr long W_OUT = W_BR + 3L * 1024 * 512;
constexpr long W_UP = W_OUT + 1024L * 1024;
constexpr long W_DOWN = W_UP + 5632L * 1024;
constexpr long W_LAYER = W_DOWN + 1024L * 2816;
constexpr size_t OFF_WT = 0;
constexpr size_t OFF_G = OFF_WT + (size_t)W_LAYER * 2 * DEPTH;
constexpr size_t OFF_BETA = OFF_G + (size_t)TT * 4 * 4;
constexpr size_t OFF_CNT = OFF_BETA + (size_t)TT * 4 * 4;
constexpr size_t OFF_H = OFF_CNT + 4096;
constexpr size_t OFF_R = OFF_H + (size_t)TT * DM * 2;
constexpr size_t OFF_M = OFF_R + (size_t)TT * PC * 2;
constexpr size_t WS_NEED = OFF_M + (size_t)TT * DM * 2;
constexpr size_t OFF_ACT = OFF_R;
constexpr size_t OFF_OUTF = OFF_R;
constexpr size_t OFF_OUTF2 = OFF_R + (size_t)TT * DFF * 2;
static_assert(OFF_OUTF2 + (size_t)TT * DM * 4 <= WS_NEED, "ws layout");

constexpr int SMEM_BYTES = 73728;
constexpr int LDT = 72;
constexpr int LDC = 132;

struct Params {
  const float* x; const float* ln_mix_pre; const float* w_in; const float* sw_sinks; const float* gdn_conv;
  const float* gdn_a_log; const float* gdn_dt_bias; const float* gdn_norm; const float* w_br[3]; const float* w_out;
  const float* ln_mix_post; const float* ln_ffn_pre; const float* w_up; const float* ffn_conv; const float* w_down;
  const float* ln_ffn_post; float* out; unsigned char* ws;
};

__shared__ __attribute__((aligned(16))) unsigned char smem_raw[SMEM_BYTES];

__device__ __forceinline__ int tid_op() { int t = threadIdx.x; asm volatile("" : "+v"(t)); return t; }
__device__ __forceinline__ int bid_op() { int b = blockIdx.x; asm volatile("" : "+s"(b)); return b; }
__device__ __forceinline__ float bf2f(u16 h) { return __uint_as_float(((unsigned)h) << 16); }
__device__ __forceinline__ u16 f2bf(float f) {
  unsigned u = __float_as_uint(f);
  u += 0x7fffu + ((u >> 16) & 1u);
  return (u16)(u >> 16);
}
__device__ __forceinline__ unsigned pack2(float a, float b) { return (unsigned)f2bf(a) | ((unsigned)f2bf(b) << 16); }
__device__ __forceinline__ float lo16(unsigned w) { return __uint_as_float(w << 16); }
__device__ __forceinline__ float hi16(unsigned w) { return __uint_as_float(w & 0xffff0000u); }
__device__ __forceinline__ float wave_sum(float v) {
#pragma unroll
  for (int m = 32; m >= 1; m >>= 1) v += __shfl_xor(v, m);
  return v;
}
__device__ __forceinline__ float sigmoidf_(float x) { return 1.f / (1.f + __expf(-x)); }
__device__ __forceinline__ float softplusf_(float x) { return fmaxf(x, 0.f) + __logf(1.f + __expf(-fabsf(x))); }

__device__ void transpose_job(const Params& p, int job) {
  const int layer = job / 4608;
  int r = job % 4608;
  const float* src; long ld; int K; long dsto; int col0; int nt, kt;
  u16* wt = (u16*)(p.ws + OFF_WT) + (long)layer * W_LAYER;
  if (r < 1088) { K = 1024; nt = r / 16; kt = r % 16; src = p.w_in + (long)layer * DM * INC; ld = INC; col0 = nt * 64; dsto = W_IN; }
  else if (r < 1856) { r -= 1088; K = 1024; nt = r / 16; kt = r % 16; src = p.w_in + (long)layer * DM * INC; ld = INC; col0 = 4360 + nt * 64; dsto = W_GATE; }
  else if (r < 2240) { r -= 1856; const int br = r / 128; r %= 128; K = 512; nt = r / 8; kt = r % 8; src = p.w_br[br] + (long)layer * 512 * 1024; ld = 1024; col0 = nt * 64; dsto = W_BR + (long)br * 1024 * 512; }
  else if (r < 2496) { r -= 2240; K = 1024; nt = r / 16; kt = r % 16; src = p.w_out + (long)layer * 1024 * 1024; ld = 1024; col0 = nt * 64; dsto = W_OUT; }
  else if (r < 3904) { r -= 2496; K = 1024; nt = r / 16; kt = r % 16; src = p.w_up + (long)layer * 1024 * 5632; ld = 5632; col0 = (nt & 1) * DFF + (nt >> 1) * 64; dsto = W_UP; }
  else { r -= 3904; K = 2816; nt = r / 44; kt = r % 44; src = p.w_down + (long)layer * 2816 * 1024; ld = 1024; col0 = nt * 64; dsto = W_DOWN; }
  float* tile = (float*)smem_raw;
  const int tid = tid_op();
  __syncthreads();
  {
    const int tx = tid & 63, ty = tid >> 6;
    const float* s = src + (long)(kt * 64) * ld + col0 + tx;
#pragma unroll 4
    for (int kk = ty; kk < 64; kk += 4) tile[kk * 65 + tx] = s[(long)kk * ld];
  }
  __syncthreads();
  {
    const int c2 = tid & 31, r0 = tid >> 5;
    unsigned* d = (unsigned*)(wt + dsto + (long)(nt * 64) * K + kt * 64);
#pragma unroll
    for (int i = 0; i < 8; ++i) {
      const int rr = r0 + 8 * i;
      d[((long)rr * K) / 2 + c2] = pack2(tile[(2 * c2) * 65 + rr], tile[(2 * c2 + 1) * 65 + rr]);
    }
  }
}

__device__ void rownorm_phase(const Params& p, int mode, const float* upd, const float* gpost, const float* gpre, int abl) {
  const int tid = tid_op(), lane = tid & 63, wid = tid >> 6;
  float* sW = (float*)smem_raw;
  __syncthreads();
  if (abl >= 0) {
    const float* w = p.w_in + (long)abl * DM * INC + 4352;
    for (int k = tid; k < 1024; k += 256) {
      const float4 a = *(const float4*)(w + (long)k * INC);
      const float4 b = *(const float4*)(w + (long)k * INC + 4);
      sW[0 * 1024 + k] = a.x; sW[1 * 1024 + k] = a.y; sW[2 * 1024 + k] = a.z; sW[3 * 1024 + k] = a.w;
      sW[4 * 1024 + k] = b.x; sW[5 * 1024 + k] = b.y; sW[6 * 1024 + k] = b.z; sW[7 * 1024 + k] = b.w;
    }
  }
  __syncthreads();
  u16* H = (u16*)(p.ws + OFF_H);
  float* G = (float*)(p.ws + OFF_G);
  float* BT = (float*)(p.ws + OFF_BETA);
  for (int row = bid_op() * 4 + wid; row < TT; row += gridDim.x * 4) {
    float4 xv[4];
    if (mode == 0) {
#pragma unroll
      for (int i = 0; i < 4; ++i) xv[i] = *(const float4*)(p.x + (long)row * DM + lane * 4 + 256 * i);
    } else {
      float4 u[4];
      float ss = 0.f;
#pragma unroll
      for (int i = 0; i < 4; ++i) {
        u[i] = *(const float4*)(upd + (long)row * DM + lane * 4 + 256 * i);
        ss += u[i].x * u[i].x + u[i].y * u[i].y + u[i].z * u[i].z + u[i].w * u[i].w;
      }
      ss = wave_sum(ss);
      const float rs = rsqrtf(ss * (1.f / 1024.f) + 1e-6f);
#pragma unroll
      for (int i = 0; i < 4; ++i) {
        const float4 o = *(const float4*)(p.out + (long)row * DM + lane * 4 + 256 * i);
        const float4 g = *(const float4*)(gpost + lane * 4 + 256 * i);
        xv[i].x = o.x + u[i].x * rs * g.x; xv[i].y = o.y + u[i].y * rs * g.y;
        xv[i].z = o.z + u[i].z * rs * g.z; xv[i].w = o.w + u[i].w * rs * g.w;
      }
    }
#pragma unroll
    for (int i = 0; i < 4; ++i) *(float4*)(p.out + (long)row * DM + lane * 4 + 256 * i) = xv[i];
    if (gpre) {
      float ss = 0.f;
#pragma unroll
      for (int i = 0; i < 4; ++i) ss += xv[i].x * xv[i].x + xv[i].y * xv[i].y + xv[i].z * xv[i].z + xv[i].w * xv[i].w;
      ss = wave_sum(ss);
      const float rs = rsqrtf(ss * (1.f / 1024.f) + 1e-6f);
      float4 hv[4];
#pragma unroll
      for (int i = 0; i < 4; ++i) {
        const float4 g = *(const float4*)(gpre + lane * 4 + 256 * i);
        hv[i].x = xv[i].x * rs * g.x; hv[i].y = xv[i].y * rs * g.y; hv[i].z = xv[i].z * rs * g.z; hv[i].w = xv[i].w * rs * g.w;
        uint2 pk; pk.x = pack2(hv[i].x, hv[i].y); pk.y = pack2(hv[i].z, hv[i].w);
        *(uint2*)(H + (long)row * DM + lane * 4 + 256 * i) = pk;
      }
      if (abl >= 0) {
        float pj[8];
#pragma unroll
        for (int j = 0; j < 8; ++j) {
          float a = 0.f;
#pragma unroll
          for (int i = 0; i < 4; ++i) {
            const float4 w = *(const float4*)(sW + j * 1024 + lane * 4 + 256 * i);
            a += hv[i].x * w.x + hv[i].y * w.y + hv[i].z * w.z + hv[i].w * w.w;
          }
          pj[j] = wave_sum(a);
        }
        if (lane == 0) {
#pragma unroll
          for (int j = 0; j < 4; ++j) {
            const float A = __expf(p.gdn_a_log[abl * 4 + j]);
            G[(long)row * 4 + j] = -A * softplusf_(pj[j] + p.gdn_dt_bias[abl * 4 + j]);
            BT[(long)row * 4 + j] = sigmoidf_(pj[4 + j]);
          }
        }
      }
    }
  }
}

template <int NJ>
__device__ __forceinline__ void gemm_core(const u16* __restrict__ A, long lda, int grow0, int row_lo, int row_hi,
                                          const u16* __restrict__ Bt, long ldb, int K, f32x16 (&acc)[2][NJ]) {
  const int tid = tid_op(), lane = tid & 63, wid = tid >> 6, wm = wid >> 1, wn = wid & 1;
  u16* sA = (u16*)smem_raw;
  u16* sB = sA + 2 * 128 * LDT;
  const int srow = tid >> 3, sc = (tid & 7) * 8;
  uint4 ra[4], rb[2 * NJ];
  const u16* ap = A + (long)(grow0 + srow) * lda + sc;
  const u16* bp = Bt + (long)srow * ldb + sc;
  bool av[4];
#pragma unroll
  for (int i = 0; i < 4; ++i) { const int gr = grow0 + srow + 32 * i; av[i] = (gr >= row_lo) && (gr < row_hi); }
  const int nk = K / 64;
  __syncthreads();
#pragma unroll
  for (int i = 0; i < 4; ++i) ra[i] = av[i] ? *(const uint4*)(ap + (long)(32 * i) * lda) : make_uint4(0, 0, 0, 0);
#pragma unroll
  for (int i = 0; i < 2 * NJ; ++i) rb[i] = *(const uint4*)(bp + (long)(32 * i) * ldb);
#pragma unroll
  for (int i = 0; i < 4; ++i) *(uint4*)(sA + (srow + 32 * i) * LDT + sc) = ra[i];
#pragma unroll
  for (int i = 0; i < 2 * NJ; ++i) *(uint4*)(sB + (srow + 32 * i) * LDT + sc) = rb[i];
  __syncthreads();
  const int fr = lane & 31, fh = (lane >> 5) * 8;
  for (int kt = 0; kt < nk; ++kt) {
    const int buf = kt & 1;
    if (kt + 1 < nk) {
      const int k0 = (kt + 1) * 64;
#pragma unroll
      for (int i = 0; i < 4; ++i) ra[i] = av[i] ? *(const uint4*)(ap + (long)(32 * i) * lda + k0) : make_uint4(0, 0, 0, 0);
#pragma unroll
      for (int i = 0; i < 2 * NJ; ++i) rb[i] = *(const uint4*)(bp + (long)(32 * i) * ldb + k0);
    }
    const u16* cA = sA + buf * 128 * LDT + (wm * 64 + fr) * LDT + fh;
    const u16* cB = sB + buf * 128 * LDT + (wn * 32 * NJ + fr) * LDT + fh;
#pragma unroll
    for (int ks = 0; ks < 4; ++ks) {
      bf16x8 af[2], bfr[NJ];
#pragma unroll
      for (int i = 0; i < 2; ++i) af[i] = *(const bf16x8*)(cA + i * 32 * LDT + ks * 16);
#pragma unroll
      for (int j = 0; j < NJ; ++j) bfr[j] = *(const bf16x8*)(cB + j * 32 * LDT + ks * 16);
#pragma unroll
      for (int i = 0; i < 2; ++i)
#pragma unroll
        for (int j = 0; j < NJ; ++j) acc[i][j] = __builtin_amdgcn_mfma_f32_32x32x16_bf16(af[i], bfr[j], acc[i][j], 0, 0, 0);
    }
    if (kt + 1 < nk) {
      u16* dA = sA + (buf ^ 1) * 128 * LDT;
      u16* dB = sB + (buf ^ 1) * 128 * LDT;
#pragma unroll
      for (int i = 0; i < 4; ++i) *(uint4*)(dA + (srow + 32 * i) * LDT + sc) = ra[i];
#pragma unroll
      for (int i = 0; i < 2 * NJ; ++i) *(uint4*)(dB + (srow + 32 * i) * LDT + sc) = rb[i];
    }
    __syncthreads();
  }
}

template <int NJ>
__device__ __forceinline__ void acc_zero(f32x16 (&acc)[2][NJ]) {
#pragma unroll
  for (int i = 0; i < 2; ++i)
#pragma unroll
    for (int j = 0; j < NJ; ++j)
#pragma unroll
      for (int r = 0; r < 16; ++r) acc[i][j][r] = 0.f;
}

template <int NJ>
__device__ __forceinline__ void acc_to_lds(const f32x16 (&acc)[2][NJ]) {
  const int tid = tid_op(), lane = tid & 63, wid = tid >> 6, wm = wid >> 1, wn = wid & 1;
  float* sC = (float*)smem_raw;
#pragma unroll
  for (int i = 0; i < 2; ++i)
#pragma unroll
    for (int j = 0; j < NJ; ++j)
#pragma unroll
      for (int r = 0; r < 16; ++r) {
        const int row = wm * 64 + i * 32 + (r & 3) + 8 * (r >> 2) + 4 * (lane >> 5);
        const int col = wn * 32 * NJ + j * 32 + (lane & 31);
        sC[row * LDC + col] = acc[i][j][r];
      }
  __syncthreads();
}

template <int NCOL>
__device__ __forceinline__ void store_bf16_tile(u16* C, long ldc) {
  const float* sC = (const float*)smem_raw;
  const int tid = tid_op();
  constexpr int TPR = NCOL / 8;
  constexpr int RPI = 256 / TPR;
  const int r0 = tid / TPR, c = (tid % TPR) * 8;
#pragma unroll
  for (int i = 0; i < 128 / RPI; ++i) {
    const int r = r0 + RPI * i;
    const float4 a = *(const float4*)(sC + r * LDC + c);
    const float4 b = *(const float4*)(sC + r * LDC + c + 4);
    uint4 o; o.x = pack2(a.x, a.y); o.y = pack2(a.z, a.w); o.z = pack2(b.x, b.y); o.w = pack2(b.z, b.w);
    *(uint4*)(C + (long)r * ldc + c) = o;
  }
}
__device__ __forceinline__ void store_f32_tile(float* C, long ldc) {
  const float* sC = (const float*)smem_raw;
  const int tid = tid_op();
  const int r0 = tid >> 5, c = (tid & 31) * 4;
#pragma unroll 4
  for (int i = 0; i < 16; ++i) {
    const int r = r0 + 8 * i;
    *(float4*)(C + (long)r * ldc + c) = *(const float4*)(sC + r * LDC + c);
  }
}

__device__ void phase_inproj(const Params& p, int layer) {
  const u16* H = (const u16*)(p.ws + OFF_H);
  const u16* W = (const u16*)(p.ws + OFF_WT) + (long)layer * W_LAYER + W_IN;
  u16* P = (u16*)(p.ws + OFF_R);
  const int tid = tid_op(), lane = tid & 63, wid = tid >> 6;
  constexpr int N_PLAIN = 256 * 22, N_CONV = 264 * 12;
  for (int id = bid_op(); id < N_PLAIN + N_CONV; id += gridDim.x) {
    f32x16 acc[2][2];
    acc_zero<2>(acc);
    if (id < N_PLAIN) {
      const int m = id / 22, nn = id % 22;
      const int ncol = nn < 18 ? nn * 128 : 3840 + (nn - 18) * 128;
      gemm_core<2>(H, DM, m * 128, 0, TT, W + (long)ncol * DM, DM, DM, acc);
      acc_to_lds<2>(acc);
      store_bf16_tile<128>(P + (long)(m * 128) * PC + ncol, PC);
    } else {
      const int id2 = id - N_PLAIN;
      const int mt = id2 / 12, nt = id2 % 12;
      const int b = mt / 132, tt = mt % 132;
      const int grow0 = b * SEQ + 125 * tt - 3;
      const int row_lo = b * SEQ, row_hi = (b + 1) * SEQ;
      const int ncol = C_CQ + nt * 128;
      gemm_core<2>(H, DM, grow0, row_lo, row_hi, W + (long)ncol * DM, DM, DM, acc);
      acc_to_lds<2>(acc);
      const float* sC = (const float*)smem_raw;
      const float* cw = p.gdn_conv + (long)layer * 4 * 1536 + nt * 128 + 2 * lane;
      const float2 w0 = *(const float2*)(cw), w1 = *(const float2*)(cw + 1536), w2 = *(const float2*)(cw + 2 * 1536),
                   w3 = *(const float2*)(cw + 3 * 1536);
      const int rs = 3 + 32 * wid, re = min(rs + 32, 128);
      float2 x0 = *(const float2*)(sC + (rs - 3) * LDC + 2 * lane);
      float2 x1 = *(const float2*)(sC + (rs - 2) * LDC + 2 * lane);
      float2 x2 = *(const float2*)(sC + (rs - 1) * LDC + 2 * lane);
      for (int r = rs; r < re; ++r) {
        const float2 x3 = *(const float2*)(sC + r * LDC + 2 * lane);
        float ya = w0.x * x0.x + w1.x * x1.x + w2.x * x2.x + w3.x * x3.x;
        float yb = w0.y * x0.y + w1.y * x1.y + w2.y * x2.y + w3.y * x3.y;
        ya = ya * sigmoidf_(ya);
        yb = yb * sigmoidf_(yb);
        if (nt < 8) {
          const float ss = wave_sum(ya * ya + yb * yb);
          const float sc = rsqrtf(ss + 1e-6f);
          ya *= sc; yb *= sc;
        }
        const int gr = grow0 + r;
        if (gr < row_hi) *(unsigned*)(P + (long)gr * PC + ncol + 2 * lane) = pack2(ya, yb);
        x0 = x1; x1 = x2; x2 = x3;
      }
    }
  }
}

__device__ void phase_merge(const Params& p, int layer) {
  const u16* H = (const u16*)(p.ws + OFF_H);
  const u16* WL = (const u16*)(p.ws + OFF_WT) + (long)layer * W_LAYER;
  const u16* P = (const u16*)(p.ws + OFF_R);
  u16* M = (u16*)(p.ws + OFF_M);
  for (int id = bid_op(); id < 256 * 16; id += gridDim.x) {
    const int m = id / 16, n0 = (id % 16) * 64;
    f32x16 mg[2][1];
    acc_zero<1>(mg);
#pragma unroll 1
    for (int br = 0; br < 3; ++br) {
      f32x16 ga[2][1];
      acc_zero<1>(ga);
      gemm_core<1>(H, DM, m * 128, 0, TT, WL + W_GATE + (long)(br * 1024 + n0) * DM, DM, DM, ga);
#pragma unroll
      for (int i = 0; i < 2; ++i)
#pragma unroll
        for (int r = 0; r < 16; ++r) ga[i][0][r] = sigmoidf_(ga[i][0][r]);
      f32x16 ba[2][1];
      acc_zero<1>(ba);
      const int ycol = br == 0 ? C_AQ : (br == 1 ? C_BQ : C_CZ);
      gemm_core<1>(P + ycol, PC, m * 128, 0, TT, WL + W_BR + (long)br * 1024 * 512 + (long)n0 * 512, 512, 512, ba);
#pragma unroll
      for (int i = 0; i < 2; ++i)
#pragma unroll
        for (int r = 0; r < 16; ++r) mg[i][0][r] += ga[i][0][r] * ba[i][0][r];
    }
    acc_to_lds<1>(mg);
    store_bf16_tile<64>(M + (long)(m * 128) * DM + n0, DM);
  }
}

__device__ void phase_gemm_f32(const u16* A, long lda, const u16* Wt, int K, float* C) {
  for (int id = bid_op(); id < 256 * 8; id += gridDim.x) {
    const int m = id / 8, n0 = (id % 8) * 128;
    f32x16 acc[2][2];
    acc_zero<2>(acc);
    gemm_core<2>(A, lda, m * 128, 0, TT, Wt + (long)n0 * K, K, K, acc);
    acc_to_lds<2>(acc);
    store_f32_tile(C + (long)(m * 128) * DM + n0, DM);
  }
}

__device__ void phase_up(const Params& p, int layer) {
  const u16* H = (const u16*)(p.ws + OFF_H);
  const u16* W = (const u16*)(p.ws + OFF_WT) + (long)layer * W_LAYER + W_UP;
  u16* ACT = (u16*)(p.ws + OFF_ACT);
  const int tid = tid_op();
  for (int id = bid_op(); id < 262 * 44; id += gridDim.x) {
    const int mt = id / 44, nb = id % 44;
    const int b = mt / 131, tt = mt % 131;
    const int grow0 = b * SEQ + 126 * tt - 2;
    const int row_lo = b * SEQ, row_hi = (b + 1) * SEQ;
    f32x16 acc[2][2];
    acc_zero<2>(acc);
    gemm_core<2>(H, DM, grow0, row_lo, row_hi, W + (long)(nb * 128) * DM, DM, DM, acc);
    acc_to_lds<2>(acc);
    const float* sC = (const float*)smem_raw;
    const int c = tid & 63, rg = tid >> 6;
    const float* fc = p.ffn_conv + (long)layer * 3 * 5632 + nb * 64 + c;
    const float g0 = fc[0], g1 = fc[5632], g2 = fc[2 * 5632];
    const float u0 = fc[DFF], u1 = fc[5632 + DFF], u2 = fc[2 * 5632 + DFF];
    const int rs = 2 + 32 * rg, re = min(rs + 32, 128);
    float ga = sC[(rs - 2) * LDC + c], gb = sC[(rs - 1) * LDC + c];
    float ua = sC[(rs - 2) * LDC + 64 + c], ub = sC[(rs - 1) * LDC + 64 + c];
    for (int r = rs; r < re; ++r) {
      const float gc = sC[r * LDC + c], uc = sC[r * LDC + 64 + c];
      const float fg = g0 * ga + g1 * gb + g2 * gc;
      const float fu = u0 * ua + u1 * ub + u2 * uc;
      const float t = 0.7978845608028654f * (fg + 0.044715f * fg * fg * fg);
      const float ge = fg / (1.f + __expf(-2.f * t));
      const int gr = grow0 + r;
      if (gr < row_hi) ACT[(long)gr * DFF + nb * 64 + c] = f2bf(ge * fu);
      ga = gb; gb = gc; ua = ub; ub = uc;
    }
  }
}

__device__ void sb_item(u16* P, int b, int h, int qt) {
  float* sK = (float*)smem_raw;
  float* sV = sK + 64 * 64;
  const int tid = tid_op();
  const int t = qt * 256 + tid;
  const long rb = (long)b * SEQ;
  float q[64], acc[64];
  {
    const u16* qp = P + (rb + t) * PC + C_AQ + h * 64;
#pragma unroll
    for (int d = 0; d < 64; d += 8) {
      const uint4 v = *(const uint4*)(qp + d);
      q[d] = lo16(v.x) * 0.125f; q[d + 1] = hi16(v.x) * 0.125f; q[d + 2] = lo16(v.y) * 0.125f; q[d + 3] = hi16(v.y) * 0.125f;
      q[d + 4] = lo16(v.z) * 0.125f; q[d + 5] = hi16(v.z) * 0.125f; q[d + 6] = lo16(v.w) * 0.125f; q[d + 7] = hi16(v.w) * 0.125f;
    }
  }
#pragma unroll
  for (int d = 0; d < 64; ++d) acc[d] = 0.f;
  float lrem = 0.f;
  for (int kt = qt * 4 + 3; kt >= 0; --kt) {
    __syncthreads();
    {
      const int key = tid >> 2, dc = (tid & 3) * 16;
      const u16* kp = P + (rb + kt * 64 + key) * PC + C_AK + h * 64 + dc;
#pragma unroll
      for (int i = 0; i < 2; ++i) {
        const uint4 kv = *(const uint4*)(kp + 8 * i);
        const uint4 vv = *(const uint4*)(kp + 512 + 8 * i);
        float* dk = sK + key * 64 + dc + 8 * i;
        float* dv = sV + key * 64 + dc + 8 * i;
        *(float4*)dk = make_float4(lo16(kv.x), hi16(kv.x), lo16(kv.y), hi16(kv.y));
        *(float4*)(dk + 4) = make_float4(lo16(kv.z), hi16(kv.z), lo16(kv.w), hi16(kv.w));
        *(float4*)dv = make_float4(lo16(vv.x), hi16(vv.x), lo16(vv.y), hi16(vv.y));
        *(float4*)(dv + 4) = make_float4(lo16(vv.z), hi16(vv.z), lo16(vv.w), hi16(vv.w));
      }
    }
    __syncthreads();
    const int s0 = kt * 64;
    for (int j = 63; j >= 0; --j) {
      const float4* kr = (const float4*)(sK + j * 64);
      float z = 0.f;
#pragma unroll
      for (int d4 = 0; d4 < 16; ++d4) {
        const float4 kk = kr[d4];
        z += q[4 * d4] * kk.x + q[4 * d4 + 1] * kk.y + q[4 * d4 + 2] * kk.z + q[4 * d4 + 3] * kk.w;
      }
      const bool valid = (s0 + j) < t;
      const float sp = softplusf_(z);
      const float w = valid ? __expf(z - sp + lrem) : 0.f;
      lrem -= valid ? sp : 0.f;
      const float4* vr = (const float4*)(sV + j * 64);
#pragma unroll
      for (int d4 = 0; d4 < 16; ++d4) {
        const float4 vv = vr[d4];
        acc[4 * d4] += w * vv.x; acc[4 * d4 + 1] += w * vv.y; acc[4 * d4 + 2] += w * vv.z; acc[4 * d4 + 3] += w * vv.w;
      }
    }
    if (!__syncthreads_or(lrem > -104.f)) break;
  }
  {
    u16* op = P + (rb + t) * PC + C_AQ + h * 64;
#pragma unroll
    for (int d = 0; d < 64; d += 8) {
      uint4 o; o.x = pack2(acc[d], acc[d + 1]); o.y = pack2(acc[d + 2], acc[d + 3]); o.z = pack2(acc[d + 4], acc[d + 5]);
      o.w = pack2(acc[d + 6], acc[d + 7]);
      *(uint4*)(op + d) = o;
    }
  }
}

__device__ void swa_item(const Params& p, int layer, u16* P, int b, int qb, int hp) {
  u16* sKt = (u16*)smem_raw;
  u16* sVt = sKt + 255 * LDT;
  const int tid = tid_op();
  const int kvh = hp >> 1, hq = 2 * hp + (tid >> 7), qi = tid & 127;
  const int t = qb * 128 + qi;
  const int kb0 = qb * 128 - 127;
  const long rb = (long)b * SEQ;
  __syncthreads();
  for (int ch = tid; ch < 255 * 8; ch += 256) {
    const int r = ch >> 3, c = (ch & 7) * 8;
    const int pos = kb0 + r;
    uint4 kv = make_uint4(0, 0, 0, 0), vv = make_uint4(0, 0, 0, 0);
    if (pos >= 0) {
      const u16* kp = P + (rb + pos) * PC + C_BK + kvh * 64 + c;
      kv = *(const uint4*)kp;
      vv = *(const uint4*)(kp + 128);
    }
    *(uint4*)(sKt + r * LDT + c) = kv;
    *(uint4*)(sVt + r * LDT + c) = vv;
  }
  __syncthreads();
  float q[64], acc[64];
  u16* qp = P + (rb + t) * PC + C_BQ + hq * 64;
#pragma unroll
  for (int d = 0; d < 64; d += 8) {
    const uint4 v = *(const uint4*)(qp + d);
    q[d] = lo16(v.x) * 0.125f; q[d + 1] = hi16(v.x) * 0.125f; q[d + 2] = lo16(v.y) * 0.125f; q[d + 3] = hi16(v.y) * 0.125f;
    q[d + 4] = lo16(v.z) * 0.125f; q[d + 5] = hi16(v.z) * 0.125f; q[d + 6] = lo16(v.w) * 0.125f; q[d + 7] = hi16(v.w) * 0.125f;
  }
#pragma unroll
  for (int d = 0; d < 64; ++d) acc[d] = 0.f;
  const float slope = exp2f(-(float)(hq + 1));
  float m = p.sw_sinks[layer * 8 + hq], l = 1.f;
#pragma unroll 1
  for (int j = 127; j >= 0; --j) {
    const u16* kr = sKt + (qi + j) * LDT;
    float z = 0.f;
#pragma unroll
    for (int d = 0; d < 64; d += 8) {
      const uint4 kv = *(const uint4*)(kr + d);
      z += q[d] * lo16(kv.x) + q[d + 1] * hi16(kv.x) + q[d + 2] * lo16(kv.y) + q[d + 3] * hi16(kv.y) +
           q[d + 4] * lo16(kv.z) + q[d + 5] * hi16(kv.z) + q[d + 6] * lo16(kv.w) + q[d + 7] * hi16(kv.w);
    }
    const bool valid = (t - 127 + j) >= 0;
    const float sc = valid ? z - slope * (float)(127 - j) : -INFINITY;
    if (sc > m) {
      const float corr = __expf(m - sc);
      l *= corr;
#pragma unroll
      for (int d = 0; d < 64; ++d) acc[d] *= corr;
      m = sc;
    }
    const float pj = __expf(sc - m);
    l += pj;
    const u16* vr = sVt + (qi + j) * LDT;
#pragma unroll
    for (int d = 0; d < 64; d += 8) {
      const uint4 vv = *(const uint4*)(vr + d);
      acc[d] += pj * lo16(vv.x); acc[d + 1] += pj * hi16(vv.x); acc[d + 2] += pj * lo16(vv.y); acc[d + 3] += pj * hi16(vv.y);
      acc[d + 4] += pj * lo16(vv.z); acc[d + 5] += pj * hi16(vv.z); acc[d + 6] += pj * lo16(vv.w); acc[d + 7] += pj * hi16(vv.w);
    }
  }
  const float inv = 1.f / l;
#pragma unroll
  for (int d = 0; d < 64; d += 8) {
    uint4 o; o.x = pack2(acc[d] * inv, acc[d + 1] * inv); o.y = pack2(acc[d + 2] * inv, acc[d + 3] * inv);
    o.z = pack2(acc[d + 4] * inv, acc[d + 5] * inv); o.w = pack2(acc[d + 6] * inv, acc[d + 7] * inv);
    *(uint4*)(qp + d) = o;
  }
}

__device__ void gdn_item(const Params& p, int layer, u16* P, int b, int h) {
  u16* sq = (u16*)smem_raw;
  u16* sk = sq + 4096;
  u16* sv = sk + 4096;
  float* so = (float*)(sv + 4096);
  float* sg = so + 4096;
  float* sbt = sg + 32;
  const float* G = (const float*)(p.ws + OFF_G);
  const float* BT = (const float*)(p.ws + OFF_BETA);
  const int tid = tid_op(), dv = tid >> 1, half = tid & 1;
  const long rb = (long)b * SEQ;
  float S[64];
#pragma unroll
  for (int i = 0; i < 64; ++i) S[i] = 0.f;
  const float scale = 0.08838834764831845f;
  const int nr = tid >> 3, ncc = (tid & 7) * 16;
  float gn[16];
#pragma unroll
  for (int i = 0; i < 16; ++i) gn[i] = p.gdn_norm[layer * 128 + ncc + i];
  for (int c0 = 0; c0 < SEQ; c0 += 32) {
    __syncthreads();
#pragma unroll
    for (int i = 0; i < 2; ++i) {
      const int ch = tid + 256 * i;
      const int r = ch >> 4, c = (ch & 15) * 8;
      const u16* src = P + (rb + c0 + r) * PC + h * 128 + c;
      *(uint4*)(sq + r * 128 + c) = *(const uint4*)(src + C_CQ);
      *(uint4*)(sk + r * 128 + c) = *(const uint4*)(src + C_CK);
      *(uint4*)(sv + r * 128 + c) = *(const uint4*)(src + C_CV);
    }
    if (tid < 32) { sg[tid] = G[(rb + c0 + tid) * 4 + h]; sbt[tid] = BT[(rb + c0 + tid) * 4 + h]; }
    __syncthreads();
    for (int tt = 0; tt < 32; ++tt) {
      const float alpha = __expf(sg[tt]);
      const float beta = sbt[tt];
      float kf[64];
      const u16* kr = sk + tt * 128 + half * 64;
#pragma unroll
      for (int i = 0; i < 64; i += 8) {
        const uint4 w = *(const uint4*)(kr + i);
        kf[i] = lo16(w.x); kf[i + 1] = hi16(w.x); kf[i + 2] = lo16(w.y); kf[i + 3] = hi16(w.y);
        kf[i + 4] = lo16(w.z); kf[i + 5] = hi16(w.z); kf[i + 6] = lo16(w.w); kf[i + 7] = hi16(w.w);
      }
      float ks = 0.f;
#pragma unroll
      for (int i = 0; i < 64; ++i) ks += kf[i] * S[i];
      ks += __shfl_xor(ks, 1);
      const float vt = bf2f(sv[tt * 128 + dv]);
      const float vn = beta * (vt - alpha * ks);
#pragma unroll
      for (int i = 0; i < 64; ++i) S[i] = fmaf(kf[i], vn, alpha * S[i]);
      const u16* qr = sq + tt * 128 + half * 64;
      float o = 0.f;
#pragma unroll
      for (int i = 0; i < 64; i += 8) {
        const uint4 w = *(const uint4*)(qr + i);
        o += lo16(w.x) * S[i] + hi16(w.x) * S[i + 1] + lo16(w.y) * S[i + 2] + hi16(w.y) * S[i + 3] +
             lo16(w.z) * S[i + 4] + hi16(w.z) * S[i + 5] + lo16(w.w) * S[i + 6] + hi16(w.w) * S[i + 7];
      }
      o += __shfl_xor(o, 1);
      if (half == 0) so[tt * 128 + dv] = o * scale;
    }
    __syncthreads();
    {
      float ov[16];
      float ss = 0.f;
#pragma unroll
      for (int i = 0; i < 16; ++i) { ov[i] = so[nr * 128 + ncc + i]; ss += ov[i] * ov[i]; }
      ss += __shfl_xor(ss, 1); ss += __shfl_xor(ss, 2); ss += __shfl_xor(ss, 4);
      const float rs = rsqrtf(ss * (1.f / 128.f) + 1e-6f);
      u16* zp = P + (rb + c0 + nr) * PC + C_CZ + h * 128 + ncc;
#pragma unroll
      for (int i = 0; i < 2; ++i) {
        const uint4 zz = *(const uint4*)(zp + 8 * i);
        float z[8] = {lo16(zz.x), hi16(zz.x), lo16(zz.y), hi16(zz.y), lo16(zz.z), hi16(zz.z), lo16(zz.w), hi16(zz.w)};
        float y[8];
#pragma unroll
        for (int e = 0; e < 8; ++e) y[e] = ov[8 * i + e] * rs * gn[8 * i + e] * (z[e] * sigmoidf_(z[e]));
        uint4 o; o.x = pack2(y[0], y[1]); o.y = pack2(y[2], y[3]); o.z = pack2(y[4], y[5]); o.w = pack2(y[6], y[7]);
        *(uint4*)(zp + 8 * i) = o;
      }
    }
  }
}

__device__ void phase_mixers(const Params& p, int layer) {
  u16* P = (u16*)(p.ws + OFF_R);
  unsigned* cnt = (unsigned*)(p.ws + OFF_CNT) + layer;
  __shared__ int s_item;
  constexpr int N_GDN = 8, N_SB = 1024, N_SWA = 1024;
  for (;;) {
    __syncthreads();
    if (tid_op() == 0) s_item = (int)atomicAdd(cnt, 1u);
    __syncthreads();
    const int it = s_item;
    if (it >= N_GDN + N_SB + N_SWA) break;
    if (it < N_GDN) {
      gdn_item(p, layer, P, it >> 2, it & 3);
    } else if (it < N_GDN + N_SB) {
      const int k = it - N_GDN;
      const int qt = 63 - (k >> 4), bh = k & 15;
      sb_item(P, bh >> 3, bh & 7, qt);
    } else {
      const int k = it - N_GDN - N_SB;
      const int hp = k & 3, qb = (k >> 2) & 127, b = k >> 9;
      swa_item(p, layer, P, b, qb, hp);
    }
  }
}

__device__ void phase_prep(const Params& p) {
  if (bid_op() == 0 && tid_op() < 16) ((unsigned*)(p.ws + OFF_CNT))[tid_op()] = 0u;
  for (int j = bid_op(); j < 2 * 4608; j += gridDim.x) transpose_job(p, j);
  rownorm_phase(p, 0, nullptr, nullptr, p.ln_mix_pre, 0);
}

constexpr int N_PHASES = 1 + 8 * DEPTH;

__global__ void __launch_bounds__(256, 2) mega(Params p, int ph_lo, int ph_hi) {
  cg::grid_group grid = cg::this_grid();
  int ph = 0;
#define STEP(CALL)                                   \
  {                                                  \
    if (ph >= ph_lo && ph < ph_hi) {                 \
      if (ph > ph_lo) grid.sync();                   \
      CALL;                                          \
    }                                                \
    ++ph;                                            \
  }
  STEP(phase_prep(p));
#pragma unroll 1
  for (int layer = 0; layer < DEPTH; ++layer) {
    const u16* WL = (const u16*)(p.ws + OFF_WT) + (long)layer * W_LAYER;
    STEP(phase_inproj(p, layer));
    STEP(phase_mixers(p, layer));
    STEP(phase_merge(p, layer));
    STEP(phase_gemm_f32((const u16*)(p.ws + OFF_M), DM, WL + W_OUT, DM, (float*)(p.ws + OFF_OUTF)));
    STEP(rownorm_phase(p, 1, (const float*)(p.ws + OFF_OUTF), p.ln_mix_post + layer * DM, p.ln_ffn_pre + layer * DM, -1));
    STEP(phase_up(p, layer));
    STEP(phase_gemm_f32((const u16*)(p.ws + OFF_ACT), DFF, WL + W_DOWN, DFF, (float*)(p.ws + OFF_OUTF2)));
    if (layer + 1 < DEPTH) {
      STEP(rownorm_phase(p, 1, (const float*)(p.ws + OFF_OUTF2), p.ln_ffn_post + layer * DM, p.ln_mix_pre + (layer + 1) * DM, layer + 1));
    } else {
      STEP(rownorm_phase(p, 1, (const float*)(p.ws + OFF_OUTF2), p.ln_ffn_post + layer * DM, nullptr, -1));
    }
  }
#undef STEP
}

extern "C" void kernel_launch(void* const* d_in, const int* in_sizes, int n_in, void* d_out, int out_size, void* d_ws,
                              size_t ws_size, hipStream_t stream) {
  (void)in_sizes; (void)n_in; (void)out_size;
  if (ws_size < WS_NEED) { fprintf(stderr, "workspace too small: %zu < %zu\n", ws_size, (size_t)WS_NEED); return; }
  Params p{};
  p.x = (const float*)d_in[0]; p.ln_mix_pre = (const float*)d_in[1]; p.w_in = (const float*)d_in[2];
  p.sw_sinks = (const float*)d_in[3]; p.gdn_conv = (const float*)d_in[4]; p.gdn_a_log = (const float*)d_in[5];
  p.gdn_dt_bias = (const float*)d_in[6]; p.gdn_norm = (const float*)d_in[7]; p.w_br[0] = (const float*)d_in[8];
  p.w_br[1] = (const float*)d_in[9]; p.w_br[2] = (const float*)d_in[10]; p.w_out = (const float*)d_in[11];
  p.ln_mix_post = (const float*)d_in[12]; p.ln_ffn_pre = (const float*)d_in[13]; p.w_up = (const float*)d_in[14];
  p.ffn_conv = (const float*)d_in[15]; p.w_down = (const float*)d_in[16]; p.ln_ffn_post = (const float*)d_in[17];
  p.out = (float*)d_out; p.ws = (unsigned char*)d_ws;
  static int grid_blocks = 0;
  if (!grid_blocks) {
    int dev = 0, cus = 0, per_cu = 0;
    hipGetDevice(&dev);
    hipDeviceGetAttribute(&cus, hipDeviceAttributeMultiprocessorCount, dev);
    hipOccupancyMaxActiveBlocksPerMultiprocessor(&per_cu, mega, 256, 0);
    if (per_cu < 1) per_cu = 1;
    if (per_cu > 2) per_cu = 2;
    grid_blocks = cus * per_cu;
  }
#if MULTI_LAUNCH
  for (int ph = 0; ph < N_PHASES; ++ph) {
    int lo = ph, hi = ph + 1;
    void* args[] = {&p, &lo, &hi};
    hipError_t e = hipLaunchCooperativeKernel((void*)mega, dim3(grid_blocks), dim3(256), args, 0, stream);
    if (e != hipSuccess) fprintf(stderr, "launch failed: %s (grid %d)\n", hipGetErrorString(e), grid_blocks);
  }
#else
  int lo = 0, hi = N_PHASES;
  void* args[] = {&p, &lo, &hi};
  hipError_t e = hipLaunchCooperativeKernel((void*)mega, dim3(grid_blocks), dim3(256), args, 0, stream);
  if (e != hipSuccess) fprintf(stderr, "cooperative launch failed: %s (grid %d)\n", hipGetErrorString(e), grid_blocks);
#endif
}
```

```cpp
#include <hip/hip_runtime.h>
#include <hip/hip_bf16.h>
#include <hip/hip_cooperative_groups.h>
#include <cstdio>
namespace cg = cooperative_groups;

#ifndef MULTI_LAUNCH
#define MULTI_LAUNCH 0
#endif

typedef unsigned short u16;
using bf16x8 = __attribute__((ext_vector_type(8))) short;
using f32x16 = __attribute__((ext_vector_type(16))) float;
using v4u = __attribute__((ext_vector_type(4))) unsigned;
using v2u = __attribute__((ext_vector_type(2))) unsigned;

constexpr int SEQ = 16384;
constexpr int NB = 2;
constexpr int TT = NB * SEQ;
constexpr int DM = 1024;
constexpr int INC = 7432;
constexpr int PC = 4352;
constexpr int DFF = 2816;
constexpr int DEPTH = 2;
constexpr int C_AQ = 0, C_AK = 512, C_AV = 1024, C_BQ = 1536, C_BK = 2048, C_BV = 2176, C_CQ = 2304, C_CK = 2816,
              C_CV = 3328, C_CZ = 3840;
constexpr long W_IN = 0;
constexpr long W_GATE = W_IN + 4352L * 1024;
constexpr long W_BR = W_GATE + 3072L * 1024;
constexpr long W_OUT = W_BR + 3L * 1024 * 512;
constexpr long W_UP = W_OUT + 1024L * 1024;
constexpr long W_DOWN = W_UP + 5632L * 1024;
constexpr long W_LAYER = W_DOWN + 1024L * 2816;
constexpr size_t OFF_WT = 0;
constexpr size_t OFF_G = OFF_WT + (size_t)W_LAYER * 2;
constexpr size_t OFF_BETA = OFF_G + (size_t)TT * 4 * 4;
constexpr size_t OFF_CNT = OFF_BETA + (size_t)TT * 4 * 4;
constexpr size_t OFF_GL = OFF_CNT + 4096;
constexpr size_t OFF_H = OFF_GL + 8192;
constexpr size_t OFF_R = OFF_H + (size_t)TT * DM * 2;
constexpr size_t OFF_M = OFF_R + (size_t)TT * PC * 2;
constexpr size_t OFF_SIGC = OFF_M + (size_t)TT * DM * 2;
constexpr size_t WS_NEED = OFF_SIGC + (size_t)TT * DM * 2;
static_assert(WS_NEED <= ((size_t)512 << 20), "workspace budget");
constexpr size_t OFF_ACT = OFF_R;
constexpr size_t OFF_OUTF = OFF_R;
constexpr size_t OFF_OUTF2 = OFF_R + (size_t)TT * DFF * 2;
static_assert(OFF_OUTF2 + (size_t)TT * DM * 4 <= WS_NEED, "ws layout");

constexpr int SMEM_BYTES = 73728;
constexpr int LDT = 72;
constexpr int LDC = 132;

struct Params {
  const float* x; const float* ln_mix_pre; const float* w_in; const float* sw_sinks; const float* gdn_conv;
  const float* gdn_a_log; const float* gdn_dt_bias; const float* gdn_norm; const float* w_br[3]; const float* w_out;
  const float* ln_mix_post; const float* ln_ffn_pre; const float* w_up; const float* ffn_conv; const float* w_down;
  const float* ln_ffn_post; float* out; unsigned char* ws;
};

__shared__ __attribute__((aligned(16))) unsigned char smem_raw[SMEM_BYTES];

__device__ __forceinline__ int tid_op() { int t = threadIdx.x; asm volatile("" : "+v"(t)); return t; }
__device__ __forceinline__ int bid_op() { int b = blockIdx.x; asm volatile("" : "+s"(b)); return b; }
__device__ __forceinline__ float bf2f(u16 h) { return __uint_as_float(((unsigned)h) << 16); }
__device__ __forceinline__ u16 f2bf(float f) { return __builtin_bit_cast(u16, (__bf16)f); }
typedef __bf16 bf16v2 __attribute__((ext_vector_type(2)));
__device__ __forceinline__ unsigned pack2(float a, float b) {
  const bf16v2 v = {(__bf16)a, (__bf16)b};
  return __builtin_bit_cast(unsigned, v);
}
__device__ __forceinline__ float lo16(unsigned w) { return __uint_as_float(w << 16); }
__device__ __forceinline__ float hi16(unsigned w) { return __uint_as_float(w & 0xffff0000u); }
__device__ __forceinline__ float wave_sum(float v) {
#pragma unroll
  for (int m = 32; m >= 1; m >>= 1) v += __shfl_xor(v, m);
  return v;
}
__device__ __forceinline__ void lds_barrier() { asm volatile("s_waitcnt lgkmcnt(0)\n\ts_barrier" ::: "memory"); }
__device__ __forceinline__ float sigmoidf_(float x) { return 1.f / (1.f + __expf(-x)); }
__device__ __forceinline__ float softplusf_(float x) { return fmaxf(x, 0.f) + __logf(1.f + __expf(-fabsf(x))); }

__device__ __forceinline__ void transpose_job(const Params& p, int job) {
  const int layer = job / 4608;
  int r = job % 4608;
  const float* src; long ld; int K; long dsto; int col0; int nt, kt;
  u16* wt = (u16*)(p.ws + OFF_WT);
  if (r < 1088) { K = 1024; nt = r / 16; kt = r % 16; src = p.w_in + (long)layer * DM * INC; ld = INC; col0 = nt * 64; dsto = W_IN; }
  else if (r < 1856) { r -= 1088; K = 1024; nt = r / 16; kt = r % 16; src = p.w_in + (long)layer * DM * INC; ld = INC; col0 = 4360 + nt * 64; dsto = W_GATE; }
  else if (r < 2240) { r -= 1856; const int br = r / 128; r %= 128; K = 512; nt = r / 8; kt = r % 8; src = (br == 0 ? p.w_br[0] : (br == 1 ? p.w_br[1] : p.w_br[2])) + (long)layer * 512 * 1024; ld = 1024; col0 = nt * 64; dsto = W_BR + (long)br * 1024 * 512; }
  else if (r < 2496) { r -= 2240; K = 1024; nt = r / 16; kt = r % 16; src = p.w_out + (long)layer * 1024 * 1024; ld = 1024; col0 = nt * 64; dsto = W_OUT; }
  else if (r < 3904) { r -= 2496; K = 1024; nt = r / 16; kt = r % 16; src = p.w_up + (long)layer * 1024 * 5632; ld = 5632; col0 = (nt & 1) * DFF + (nt >> 1) * 64; dsto = W_UP; }
  else { r -= 3904; K = 2816; nt = r / 44; kt = r % 44; src = p.w_down + (long)layer * 2816 * 1024; ld = 1024; col0 = nt * 64; dsto = W_DOWN; }
  float* tile = (float*)smem_raw;
  const int tid = tid_op();
  __syncthreads();
  {
    const int tx = tid & 63, ty = tid >> 6;
    const float* s = src + (long)(kt * 64) * ld + col0 + tx;
#pragma unroll 4
    for (int kk = ty; kk < 64; kk += 4) tile[kk * 65 + tx] = s[(long)kk * ld];
  }
  __syncthreads();
  {
    const int c2 = tid & 31, r0 = tid >> 5;
    unsigned* d = (unsigned*)(wt + dsto + (long)(nt * 64) * K + kt * 64);
#pragma unroll
    for (int i = 0; i < 8; ++i) {
      const int rr = r0 + 8 * i;
      d[((long)rr * K) / 2 + c2] = pack2(tile[(2 * c2) * 65 + rr], tile[(2 * c2 + 1) * 65 + rr]);
    }
  }
}

__device__ __forceinline__ void rownorm_phase(const Params& p, int mode, const u16* upd, const float* gpost, const float* gpre, int abl) {
  const int tid = tid_op(), lane = tid & 63, wid = tid >> 6;
  float* sW = (float*)smem_raw;
  __syncthreads();
  if (abl >= 0) {
    const float* w = p.w_in + (long)abl * DM * INC + 4352;
    for (int k = tid; k < 1024; k += 256) {
      const float4 a = *(const float4*)(w + (long)k * INC);
      const float4 b = *(const float4*)(w + (long)k * INC + 4);
      sW[0 * 1024 + k] = a.x; sW[1 * 1024 + k] = a.y; sW[2 * 1024 + k] = a.z; sW[3 * 1024 + k] = a.w;
      sW[4 * 1024 + k] = b.x; sW[5 * 1024 + k] = b.y; sW[6 * 1024 + k] = b.z; sW[7 * 1024 + k] = b.w;
    }
  }
  __syncthreads();
  u16* H = (u16*)(p.ws + OFF_H);
  float* G = (float*)(p.ws + OFF_G);
  float* BT = (float*)(p.ws + OFF_BETA);
  for (int row = bid_op() * 4 + wid; row < TT; row += gridDim.x * 4) {
    float4 xv[4];
    if (mode == 0) {
#pragma unroll
      for (int i = 0; i < 4; ++i) xv[i] = *(const float4*)(p.x + (long)row * DM + lane * 4 + 256 * i);
    } else {
      float4 u[4];
      float ss = 0.f;
#pragma unroll
      for (int i = 0; i < 4; ++i) {
        const uint2 ub_ = *(const uint2*)(upd + (long)row * DM + lane * 4 + 256 * i);
        u[i] = make_float4(lo16(ub_.x), hi16(ub_.x), lo16(ub_.y), hi16(ub_.y));
        ss += u[i].x * u[i].x + u[i].y * u[i].y + u[i].z * u[i].z + u[i].w * u[i].w;
      }
      ss = wave_sum(ss);
      const float rs = rsqrtf(ss * (1.f / 1024.f) + 1e-6f);
#pragma unroll
      for (int i = 0; i < 4; ++i) {
        const float4 o = *(const float4*)(p.out + (long)row * DM + lane * 4 + 256 * i);
        const float4 g = *(const float4*)(gpost + lane * 4 + 256 * i);
        xv[i].x = o.x + u[i].x * rs * g.x; xv[i].y = o.y + u[i].y * rs * g.y;
        xv[i].z = o.z + u[i].z * rs * g.z; xv[i].w = o.w + u[i].w * rs * g.w;
      }
    }
#pragma unroll
    for (int i = 0; i < 4; ++i) *(float4*)(p.out + (long)row * DM + lane * 4 + 256 * i) = xv[i];
    if (gpre) {
      float ss = 0.f;
#pragma unroll
      for (int i = 0; i < 4; ++i) ss += xv[i].x * xv[i].x + xv[i].y * xv[i].y + xv[i].z * xv[i].z + xv[i].w * xv[i].w;
      ss = wave_sum(ss);
      const float rs = rsqrtf(ss * (1.f / 1024.f) + 1e-6f);
      float4 hv[4];
#pragma unroll
      for (int i = 0; i < 4; ++i) {
        const float4 g = *(const float4*)(gpre + lane * 4 + 256 * i);
        hv[i].x = xv[i].x * rs * g.x; hv[i].y = xv[i].y * rs * g.y; hv[i].z = xv[i].z * rs * g.z; hv[i].w = xv[i].w * rs * g.w;
        uint2 pk; pk.x = pack2(hv[i].x, hv[i].y); pk.y = pack2(hv[i].z, hv[i].w);
        *(uint2*)(H + (long)row * DM + lane * 4 + 256 * i) = pk;
      }
      if (abl >= 0) {
        float pj[8];
#pragma unroll
        for (int j = 0; j < 8; ++j) {
          float a = 0.f;
#pragma unroll
          for (int i = 0; i < 4; ++i) {
            const float4 w = *(const float4*)(sW + j * 1024 + lane * 4 + 256 * i);
            a += hv[i].x * w.x + hv[i].y * w.y + hv[i].z * w.z + hv[i].w * w.w;
          }
          pj[j] = wave_sum(a);
        }
        if (lane == 0) {
#pragma unroll
          for (int j = 0; j < 4; ++j) {
            const float A = __expf(p.gdn_a_log[abl * 4 + j]);
            G[(long)row * 4 + j] = -A * softplusf_(pj[j] + p.gdn_dt_bias[abl * 4 + j]);
            BT[(long)row * 4 + j] = sigmoidf_(pj[4 + j]);
          }
        }
      }
    }
  }
}

template <int NJ, bool MASK = false>
__device__ __forceinline__ void gemm_core(const u16* __restrict__ A, long lda, int grow0, int row_lo, int row_hi,
                                          const u16* __restrict__ Bt, long ldb, int K, f32x16 (&acc)[2][NJ]) {
  const int tid = tid_op(), lane = tid & 63, wid = tid >> 6, wm = wid >> 1, wn = wid & 1;
  u16* sA = (u16*)smem_raw;
  u16* sB = sA + 2 * 128 * LDT;
  const int srow = tid >> 3, sc = (tid & 7) * 8;
  v4u ra0[4], rb0[2 * NJ], ra1[4], rb1[2 * NJ], ra2[4], rb2[2 * NJ], ra3[4], rb3[2 * NJ];
  const u16* bp = Bt + (long)srow * ldb + sc;
  const u16* apr[4];
  bool av[4];
#pragma unroll
  for (int i = 0; i < 4; ++i) {
    const int gr = grow0 + srow + 32 * i;
    av[i] = (gr >= row_lo) && (gr < row_hi);
    apr[i] = A + (long)min(max(gr, row_lo), row_hi - 1) * lda + sc;
  }
  const int nk = K / 64;
  const v4u zero4 = {0u, 0u, 0u, 0u};
#define G_LOAD(RA, RB, KT)                                                                              \
  {                                                                                                     \
    const int k0_ = (KT) * 64;                                                                          \
    _Pragma("unroll") for (int i = 0; i < 4; ++i) RA[i] = *(const v4u*)(apr[i] + k0_);                   \
    _Pragma("unroll") for (int i = 0; i < 2 * NJ; ++i) RB[i] = *(const v4u*)(bp + (long)(32 * i) * ldb + k0_);           \
  }
#define G_STORE(RA, RB, BUF)                                                                            \
  {                                                                                                     \
    u16* dA_ = sA + (BUF) * 128 * LDT;                                                                  \
    u16* dB_ = sB + (BUF) * 128 * LDT;                                                                  \
    _Pragma("unroll") for (int i = 0; i < 4; ++i) *(v4u*)(dA_ + (srow + 32 * i) * LDT + sc) = av[i] ? RA[i] : zero4; \
    _Pragma("unroll") for (int i = 0; i < 2 * NJ; ++i) *(v4u*)(dB_ + (srow + 32 * i) * LDT + sc) = RB[i]; \
  }
#define G_FRAGS(ST, KS)                                                                                 \
  {                                                                                                     \
    _Pragma("unroll") for (int i = 0; i < 2; ++i) af[ST][i] = *(const bf16x8*)(cA + i * 32 * LDT + (KS) * 16); \
    _Pragma("unroll") for (int j = 0; j < NJ; ++j) bfr[ST][j] = *(const bf16x8*)(cB + j * 32 * LDT + (KS) * 16); \
  }
#define G_COMPUTE(BUF, RA, RB, DOST, LA, LB, LKT, NEXT)                                                 \
  {                                                                                                     \
    const u16* cA = sA + (BUF) * 128 * LDT + (wm * 64 + fr) * LDT + fh;                                 \
    const u16* cB = sB + (BUF) * 128 * LDT + (wn * 32 * NJ + fr) * LDT + fh;                            \
    const u16* nA = sA + ((BUF) ^ 1) * 128 * LDT + (wm * 64 + fr) * LDT + fh;                           \
    const u16* nB = sB + ((BUF) ^ 1) * 128 * LDT + (wn * 32 * NJ + fr) * LDT + fh;                      \
    u16* dA_ = sA + ((BUF) ^ 1) * 128 * LDT + srow * LDT + sc;                                          \
    u16* dB_ = sB + ((BUF) ^ 1) * 128 * LDT + srow * LDT + sc;                                          \
    const bool dost_ = (DOST);                                                                          \
    const bool next_ = (NEXT);                                                                          \
    const int lk0_ = (LKT) * 64;                                                                        \
    constexpr int NMF = 2 * NJ, NFR = 2 + NJ, NE = 4 + 2 * NJ;                                          \
    _Pragma("unroll") for (int ks = 0; ks < 4; ++ks) {                                                  \
                  \
      if (ks == 3) lds_barrier();                                                                       \
      _Pragma("unroll") for (int m = 0; m < NMF; ++m) {                                                 \
        const int t_ = ks * NMF + m;                                                                    \
        if (ks < 3) {                                                                                   \
          _Pragma("unroll") for (int f = 0; f < NFR; ++f)                                               \
            if ((f * NMF) / NFR == m) {                                                                 \
              if (f < 2) af[(ks + 1) & 1][f] = *(const bf16x8*)(cA + f * 32 * LDT + (ks + 1) * 16);     \
              else bfr[(ks + 1) & 1][f - 2] = *(const bf16x8*)(cB + (f - 2) * 32 * LDT + (ks + 1) * 16); \
            }                                                                                           \
        } else if (next_) {                                                                             \
          _Pragma("unroll") for (int f = 0; f < NFR; ++f)                                               \
            if ((f * NMF) / NFR == m) {                                                                 \
              if (f < 2) af[0][f] = *(const bf16x8*)(nA + f * 32 * LDT);                                \
              else bfr[0][f - 2] = *(const bf16x8*)(nB + (f - 2) * 32 * LDT);                           \
            }                                                                                           \
        }                                                                                               \
        _Pragma("unroll") for (int e = 0; e < NE; ++e) {                                                \
          if ((e * 4 * NMF) / NE == t_) {                                                               \
            if (e < 4) LA[e] = *(const v4u*)(apr[e] + lk0_);                                            \
            else LB[e - 4] = *(const v4u*)(bp + (long)(32 * (e - 4)) * ldb + lk0_);                     \
          }                                                                                             \
          if (dost_ && (e * 3 * NMF) / NE == t_) {                                                      \
            if (e < 4) *(v4u*)(dA_ + 32 * e * LDT) = (!MASK || av[e]) ? RA[e] : zero4;                  \
            else *(v4u*)(dB_ + 32 * (e - 4) * LDT) = RB[e - 4];                                         \
          }                                                                                             \
        }                                                                                               \
        __builtin_amdgcn_sched_barrier(0);                                                              \
        acc[m / NJ][m % NJ] = __builtin_amdgcn_mfma_f32_32x32x16_bf16(af[ks & 1][m / NJ], bfr[ks & 1][m % NJ], \
                                                                       acc[m / NJ][m % NJ], 0, 0, 0);   \
        __builtin_amdgcn_sched_barrier(0);                                                              \
      }                                                                                                 \
    }                                                                                                   \
  }
  __syncthreads();
  G_LOAD(ra0, rb0, 0);
  G_LOAD(ra1, rb1, 1);
  G_LOAD(ra2, rb2, 2);
  G_STORE(ra0, rb0, 0);
  __syncthreads();
  const int fr = lane & 31, fh = (lane >> 5) * 8;
  bf16x8 af[2][2], bfr[2][NJ];
#pragma unroll
  for (int i = 0; i < 2; ++i) af[0][i] = *(const bf16x8*)(sA + (wm * 64 + fr + i * 32) * LDT + fh);
#pragma unroll
  for (int j = 0; j < NJ; ++j) bfr[0][j] = *(const bf16x8*)(sB + (wn * 32 * NJ + fr + j * 32) * LDT + fh);
  for (int kt = 0; kt < nk; kt += 4) {
    G_COMPUTE(0, ra1, rb1, true, ra3, rb3, min(kt + 3, nk - 1), true);
    G_COMPUTE(1, ra2, rb2, true, ra0, rb0, min(kt + 4, nk - 1), true);
    G_COMPUTE(0, ra3, rb3, true, ra1, rb1, min(kt + 5, nk - 1), true);
    G_COMPUTE(1, ra0, rb0, kt + 4 < nk, ra2, rb2, min(kt + 6, nk - 1), kt + 4 < nk);
  }
#undef G_LOAD
#undef G_STORE
#undef G_COMPUTE
#undef G_FRAGS
}


template <int NJ>
__device__ __forceinline__ void gemm_glds(const u16* __restrict__ A, long lda, int grow0, const u16* __restrict__ Bt,
                                          long ldb, int K, f32x16 (&acc)[2][NJ]) {
  const int tid = tid_op(), lane = tid & 63, wid = tid >> 6, wm = wid >> 1, wn = wid & 1;
  const int fr = lane & 31, h = lane >> 5;
  unsigned char* sm = smem_raw;
  constexpr int STG = 32768, BOFF = 16384;
  const int lrow = tid >> 3, lcp = tid & 7, lsw = (lrow >> 1) & 7;
  const u16* ag = A + (long)(grow0 + lrow) * lda + ((lcp ^ lsw) * 8);
  const u16* bg = Bt + (long)lrow * ldb + ((lcp ^ lsw) * 8);
  const int nk = K / 64;
  const int fsw = (fr >> 1) & 7;
  int foff[4];
#pragma unroll
  for (int ks = 0; ks < 4; ++ks) foff[ks] = ((2 * ks + h) ^ fsw) * 16;
  const unsigned char* fA = sm + (wm * 64 + fr) * 128;
  const unsigned char* fB = sm + BOFF + (wn * 32 * NJ + fr) * 128;
#define L_ISSUE_A(STAGE, KT, I) \
  __builtin_amdgcn_global_load_lds((const unsigned*)(ag + (long)(32 * (I)) * lda + (KT) * 64), \
                                   (__attribute__((address_space(3))) unsigned*)(sm + (STAGE) * STG + (I) * 4096 + tid * 16), 16, 0, 0)
#define L_ISSUE_B(STAGE, KT, I) \
  __builtin_amdgcn_global_load_lds((const unsigned*)(bg + (long)(32 * (I)) * ldb + (KT) * 64), \
                                   (__attribute__((address_space(3))) unsigned*)(sm + (STAGE) * STG + BOFF + (I) * 4096 + tid * 16), 16, 0, 0)
#define L_FRAGS(ST, STAGE, KS)                                                                          \
  {                                                                                                     \
    _Pragma("unroll") for (int i = 0; i < 2; ++i)                                                       \
      af[ST][i] = *(const bf16x8*)(fA + (STAGE) * STG + i * 32 * 128 + foff[KS]);                       \
    _Pragma("unroll") for (int j = 0; j < NJ; ++j)                                                      \
      bfr[ST][j] = *(const bf16x8*)(fB + (STAGE) * STG + j * 32 * 128 + foff[KS]);                      \
  }
  lds_barrier();
#pragma unroll
  for (int i = 0; i < 4; ++i) L_ISSUE_A(0, 0, i);
#pragma unroll
  for (int i = 0; i < 2 * NJ; ++i) L_ISSUE_B(0, 0, i);
#pragma unroll
  for (int i = 0; i < 4; ++i) L_ISSUE_A(1, 1, i);
#pragma unroll
  for (int i = 0; i < 2 * NJ; ++i) L_ISSUE_B(1, 1, i);
  if (NJ == 2) asm volatile("s_waitcnt vmcnt(8)" ::: "memory");
  else asm volatile("s_waitcnt vmcnt(6)" ::: "memory");
  lds_barrier();
  bf16x8 af[2][2], bfr[2][NJ];
  L_FRAGS(0, 0, 0);
  constexpr int NMF = 2 * NJ, NFR = 2 + NJ, NE = 4 + 2 * NJ;
#define L_TILE(STAGE, KT)                                                                               \
  {                                                                                                     \
    const bool next_ = (KT) + 1 < nk;                                                                   \
    const bool load2_ = (KT) + 2 < nk;                                                                  \
    _Pragma("unroll") for (int ks = 0; ks < 4; ++ks) {                                                  \
      if (ks == 3) {                                                                                    \
        asm volatile("s_waitcnt vmcnt(0)" ::: "memory");     \
        lds_barrier();                                                                                  \
      }                                                                                                 \
      _Pragma("unroll") for (int m = 0; m < NMF; ++m) {                                                 \
        if (ks < 3) {                                                                                   \
          _Pragma("unroll") for (int f = 0; f < NFR; ++f)                                               \
            if ((f * NMF) / NFR == m) {                                                                 \
              if (f < 2) af[(ks + 1) & 1][f] = *(const bf16x8*)(fA + (STAGE) * STG + f * 32 * 128 + foff[(ks + 1) & 3]); \
              else bfr[(ks + 1) & 1][f - 2] = *(const bf16x8*)(fB + (STAGE) * STG + (f - 2) * 32 * 128 + foff[(ks + 1) & 3]); \
            }                                                                                           \
        } else {                                                                                        \
          if (next_) {                                                                                  \
            _Pragma("unroll") for (int f = 0; f < NFR; ++f)                                             \
              if ((f * NMF) / NFR == m) {                                                               \
                if (f < 2) af[0][f] = *(const bf16x8*)(fA + ((STAGE) ^ 1) * STG + f * 32 * 128 + foff[0]); \
                else bfr[0][f - 2] = *(const bf16x8*)(fB + ((STAGE) ^ 1) * STG + (f - 2) * 32 * 128 + foff[0]); \
              }                                                                                         \
          }                                                                                             \
          if (load2_) {                                                                                 \
            _Pragma("unroll") for (int e = 0; e < NE; ++e)                                              \
              if ((e * NMF) / NE == m) {                                                                \
                if (e < 4) L_ISSUE_A(STAGE, (KT) + 2, e);                                               \
                else L_ISSUE_B(STAGE, (KT) + 2, e - 4);                                                 \
              }                                                                                         \
          }                                                                                             \
        }                                                                                               \
        __builtin_amdgcn_sched_barrier(0);                                                              \
        acc[m / NJ][m % NJ] = __builtin_amdgcn_mfma_f32_32x32x16_bf16(af[ks & 1][m / NJ], bfr[ks & 1][m % NJ], \
                                                                       acc[m / NJ][m % NJ], 0, 0, 0);   \
        __builtin_amdgcn_sched_barrier(0);                                                              \
      }                                                                                                 \
    }                                                                                                   \
  }
  for (int kt = 0; kt < nk; kt += 2) {
    L_TILE(0, kt);
    L_TILE(1, kt + 1);
  }
#undef L_ISSUE_A
#undef L_ISSUE_B
#undef L_FRAGS
#undef L_TILE
}


template <int OFF>
__device__ __forceinline__ bf16x8 lds_rd128(unsigned addr) {
  bf16x8 r;
  asm volatile("ds_read_b128 %0, %1 offset:%2" : "=v"(r) : "v"(addr), "n"(OFF));
  return r;
}
template <int N>
__device__ __forceinline__ void lgk_wait() { asm volatile("s_waitcnt lgkmcnt(%0)" ::"n"(N)); }

__device__ __forceinline__ void gemm_glds2(const u16* __restrict__ A, long lda, int grow0, const u16* __restrict__ Bt,
                                           long ldb, int K, f32x16 (&acc)[2][2]) {
  const int tid = tid_op(), lane = tid & 63, wid = tid >> 6, wm = wid >> 1, wn = wid & 1;
  const int fr = lane & 31, h = lane >> 5;
  unsigned char* sm = smem_raw;
  constexpr int STG = 32768, BOFF = 16384;
  const int lrow = tid >> 3, lcp = tid & 7, lsw = (lrow >> 1) & 7;
  const u16* ag = A + (long)(grow0 + lrow) * lda + ((lcp ^ lsw) * 8);
  const u16* bg = Bt + (long)lrow * ldb + ((lcp ^ lsw) * 8);
  const int nk = K / 64;
  const int fsw = (fr >> 1) & 7;
  const unsigned lbase = (unsigned)(unsigned long long)(__attribute__((address_space(3))) unsigned char*)smem_raw;
  unsigned aA[4], aB[4];
#pragma unroll
  for (int ks = 0; ks < 4; ++ks) {
    const unsigned fo = ((2 * ks + h) ^ fsw) * 16;
    aA[ks] = lbase + (wm * 64 + fr) * 128 + fo;
    aB[ks] = lbase + BOFF + (wn * 64 + fr) * 128 + fo;
  }
#define L_ISSUE_A(STAGE, KT, I) \
  __builtin_amdgcn_global_load_lds((const unsigned*)(ag + (long)(32 * (I)) * lda + (KT) * 64), \
                                   (__attribute__((address_space(3))) unsigned*)(sm + (STAGE) * STG + (I) * 4096 + tid * 16), 16, 0, 0)
#define L_ISSUE_B(STAGE, KT, I) \
  __builtin_amdgcn_global_load_lds((const unsigned*)(bg + (long)(32 * (I)) * ldb + (KT) * 64), \
                                   (__attribute__((address_space(3))) unsigned*)(sm + (STAGE) * STG + BOFF + (I) * 4096 + tid * 16), 16, 0, 0)
#define MF(I, J, AF, BF) acc[I][J] = __builtin_amdgcn_mfma_f32_32x32x16_bf16(AF, BF, acc[I][J], 0, 0, 0)
#define SB0 __builtin_amdgcn_sched_barrier(0)
  lds_barrier();
#pragma unroll
  for (int i = 0; i < 4; ++i) L_ISSUE_A(0, 0, i);
#pragma unroll
  for (int i = 0; i < 4; ++i) L_ISSUE_B(0, 0, i);
#pragma unroll
  for (int i = 0; i < 4; ++i) L_ISSUE_A(1, 1, i);
#pragma unroll
  for (int i = 0; i < 4; ++i) L_ISSUE_B(1, 1, i);
  asm volatile("s_waitcnt vmcnt(8)" ::: "memory");
  lds_barrier();
  bf16x8 a0[2], b0[2], a1[2], b1[2];
  a0[0] = lds_rd128<0>(aA[0]); a0[1] = lds_rd128<4096>(aA[0]);
  b0[0] = lds_rd128<0>(aB[0]); b0[1] = lds_rd128<4096>(aB[0]);
#define KSTEP(SOFF, KSN, CA, CB, NA, NB)                                      \
  SB0; NA[0] = lds_rd128<SOFF>(aA[KSN]);          lgk_wait<1>(); SB0; MF(0, 0, CA[0], CB[0]); \
  SB0; NA[1] = lds_rd128<SOFF + 4096>(aA[KSN]);   lgk_wait<2>(); SB0; MF(0, 1, CA[0], CB[1]); \
  SB0; NB[0] = lds_rd128<SOFF>(aB[KSN]);          lgk_wait<3>(); SB0; MF(1, 0, CA[1], CB[0]); \
  SB0; NB[1] = lds_rd128<SOFF + 4096>(aB[KSN]);   lgk_wait<4>(); SB0; MF(1, 1, CA[1], CB[1]); SB0;
#define KLAST(STAGE, NOFF, KT)                                                                          \
  asm volatile("s_waitcnt vmcnt(0)" ::: "memory");                                                      \
  lds_barrier();                                                                                        \
  SB0; if (next_) a0[0] = lds_rd128<NOFF>(aA[0]);                                                       \
  if (load2_) { L_ISSUE_A(STAGE, (KT) + 2, 0); L_ISSUE_A(STAGE, (KT) + 2, 1); }                         \
  SB0; MF(0, 0, a1[0], b1[0]);                                                                          \
  SB0; if (next_) a0[1] = lds_rd128<NOFF + 4096>(aA[0]);                                                \
  if (load2_) { L_ISSUE_A(STAGE, (KT) + 2, 2); L_ISSUE_A(STAGE, (KT) + 2, 3); }                         \
  SB0; MF(0, 1, a1[0], b1[1]);                                                                          \
  SB0; if (next_) b0[0] = lds_rd128<NOFF>(aB[0]);                                                       \
  if (load2_) { L_ISSUE_B(STAGE, (KT) + 2, 0); L_ISSUE_B(STAGE, (KT) + 2, 1); }                         \
  SB0; MF(1, 0, a1[1], b1[0]);                                                                          \
  SB0; if (next_) b0[1] = lds_rd128<NOFF + 4096>(aB[0]);                                                \
  if (load2_) { L_ISSUE_B(STAGE, (KT) + 2, 2); L_ISSUE_B(STAGE, (KT) + 2, 3); }                         \
  SB0; MF(1, 1, a1[1], b1[1]); SB0;
  for (int kt = 0; kt < nk; kt += 2) {
    {
      const bool next_ = true, load2_ = kt + 2 < nk;
      KSTEP(0, 1, a0, b0, a1, b1)
      KSTEP(0, 2, a1, b1, a0, b0)
      KSTEP(0, 3, a0, b0, a1, b1)
      KLAST(0, 32768, kt)
    }
    {
      const bool next_ = kt + 2 < nk, load2_ = kt + 3 < nk;
      KSTEP(32768, 1, a0, b0, a1, b1)
      KSTEP(32768, 2, a1, b1, a0, b0)
      KSTEP(32768, 3, a0, b0, a1, b1)
      KLAST(1, 0, kt + 1)
    }
  }
  lgk_wait<0>();
#undef L_ISSUE_A
#undef L_ISSUE_B
#undef MF
#undef SB0
#undef KSTEP
#undef KLAST
}

template <int NJ>
__device__ __forceinline__ void acc_zero(f32x16 (&acc)[2][NJ]) {
#pragma unroll
  for (int i = 0; i < 2; ++i)
#pragma unroll
    for (int j = 0; j < NJ; ++j)
#pragma unroll
      for (int r = 0; r < 16; ++r) acc[i][j][r] = 0.f;
}

template <int NJ>
__device__ __forceinline__ void acc_to_lds(const f32x16 (&acc)[2][NJ]) {
  const int tid = tid_op(), lane = tid & 63, wid = tid >> 6, wm = wid >> 1, wn = wid & 1;
  float* sC = (float*)smem_raw;
#pragma unroll
  for (int i = 0; i < 2; ++i)
#pragma unroll
    for (int j = 0; j < NJ; ++j)
#pragma unroll
      for (int r = 0; r < 16; ++r) {
        const int row = wm * 64 + i * 32 + (r & 3) + 8 * (r >> 2) + 4 * (lane >> 5);
        const int col = wn * 32 * NJ + j * 32 + (lane & 31);
        sC[row * LDC + col] = acc[i][j][r];
      }
  __syncthreads();
}

template <int NCOL>
__device__ __forceinline__ void store_bf16_tile(u16* C, long ldc) {
  const float* sC = (const float*)smem_raw;
  const int tid = tid_op();
  constexpr int TPR = NCOL / 8;
  constexpr int RPI = 256 / TPR;
  const int r0 = tid / TPR, c = (tid % TPR) * 8;
#pragma unroll
  for (int i = 0; i < 128 / RPI; ++i) {
    const int r = r0 + RPI * i;
    const float4 a = *(const float4*)(sC + r * LDC + c);
    const float4 b = *(const float4*)(sC + r * LDC + c + 4);
    uint4 o; o.x = pack2(a.x, a.y); o.y = pack2(a.z, a.w); o.z = pack2(b.x, b.y); o.w = pack2(b.z, b.w);
    *(uint4*)(C + (long)r * ldc + c) = o;
  }
}
__device__ __forceinline__ void store_f32_tile(float* C, long ldc) {
  const float* sC = (const float*)smem_raw;
  const int tid = tid_op();
  const int r0 = tid >> 5, c = (tid & 31) * 4;
#pragma unroll 4
  for (int i = 0; i < 16; ++i) {
    const int r = r0 + 8 * i;
    *(float4*)(C + (long)r * ldc + c) = *(const float4*)(sC + r * LDC + c);
  }
}

__device__ __forceinline__ int xcd_linear(int k) {
  const int G = gridDim.x, bid = bid_op();
  return k * G + (bid & 7) * (G >> 3) + (bid >> 3);
}
__device__ __forceinline__ void tile_mn(int L, int Mt, int Nt, int& m, int& n) {
  const int band = L / (8 * Nt), rem = L - band * 8 * Nt;
  const int R = min(8, Mt - 8 * band);
  n = rem / R;
  m = 8 * band + (rem - n * R);
}

__device__ __forceinline__ void phase_inproj(const Params& p, int layer) {
  const u16* H = (const u16*)(p.ws + OFF_H);
  const u16* W = (const u16*)(p.ws + OFF_WT) + W_IN;
  u16* P = (u16*)(p.ws + OFF_R);
  const int tid = tid_op(), lane = tid & 63, wid = tid >> 6;
  constexpr int N_PLAIN = 256 * 22, N_CONV = 264 * 12;
  for (int kk = 0;; ++kk) {
    const int id = xcd_linear(kk);
    if (kk * (int)gridDim.x >= N_PLAIN + N_CONV) break;
    if (id >= N_PLAIN + N_CONV) continue;
    f32x16 acc[2][2];
    acc_zero<2>(acc);
    if (id < N_PLAIN) {
      int m, nn;
      tile_mn(id, 256, 22, m, nn);
      const int ncol = nn < 18 ? nn * 128 : 3840 + (nn - 18) * 128;
      gemm_glds2(H, DM, m * 128, W + (long)ncol * DM, DM, DM, acc);
      acc_to_lds<2>(acc);
      store_bf16_tile<128>(P + (long)(m * 128) * PC + ncol, PC);
    } else {
      int mt, nt;
      tile_mn(id - N_PLAIN, 264, 12, mt, nt);
      const int b = mt / 132, tt = mt % 132;
      const int grow0 = b * SEQ + 125 * tt - 3;
      const int row_lo = b * SEQ, row_hi = (b + 1) * SEQ;
      const int ncol = C_CQ + nt * 128;
      if (grow0 >= row_lo && grow0 + 128 <= row_hi) gemm_glds2(H, DM, grow0, W + (long)ncol * DM, DM, DM, acc);
      else gemm_core<2, true>(H, DM, grow0, row_lo, row_hi, W + (long)ncol * DM, DM, DM, acc);
      acc_to_lds<2>(acc);
      const float* sC = (const float*)smem_raw;
      const float* cw = p.gdn_conv + (long)layer * 4 * 1536 + nt * 128 + 2 * lane;
      const float2 w0 = *(const float2*)(cw), w1 = *(const float2*)(cw + 1536), w2 = *(const float2*)(cw + 2 * 1536),
                   w3 = *(const float2*)(cw + 3 * 1536);
      const int rs = 3 + 32 * wid, re = min(rs + 32, 128);
      float2 x0 = *(const float2*)(sC + (rs - 3) * LDC + 2 * lane);
      float2 x1 = *(const float2*)(sC + (rs - 2) * LDC + 2 * lane);
      float2 x2 = *(const float2*)(sC + (rs - 1) * LDC + 2 * lane);
      for (int r = rs; r < re; ++r) {
        const float2 x3 = *(const float2*)(sC + r * LDC + 2 * lane);
        float ya = w0.x * x0.x + w1.x * x1.x + w2.x * x2.x + w3.x * x3.x;
        float yb = w0.y * x0.y + w1.y * x1.y + w2.y * x2.y + w3.y * x3.y;
        ya = ya * sigmoidf_(ya);
        yb = yb * sigmoidf_(yb);
        if (nt < 8) {
          const float ss = wave_sum(ya * ya + yb * yb);
          const float sc = rsqrtf(ss + 1e-6f);
          ya *= sc; yb *= sc;
        }
        const int gr = grow0 + r;
        if (gr < row_hi) *(unsigned*)(P + (long)gr * PC + ncol + 2 * lane) = pack2(ya, yb);
        x0 = x1; x1 = x2; x2 = x3;
      }
    }
  }
}

__device__ __forceinline__ void merge_tile(const Params& p, int m, int nq, int mode) {
  const u16* H = (const u16*)(p.ws + OFF_H);
  const u16* WL = (const u16*)(p.ws + OFF_WT);
  u16* P = (u16*)(p.ws + OFF_R);
  u16* SIGC = (u16*)(p.ws + OFF_SIGC);
  const int n0 = nq * 64;
  const int tid = tid_op();
  const int r0 = tid >> 3, c = (tid & 7) * 8;
  u16* part = P + (long)(m * 128) * PC + C_AK + n0;
  u16* sigp = SIGC + (long)(m * 128) * DM + n0;
  if (mode == 1) {
    f32x16 mg[2][1];
    acc_zero<1>(mg);
#pragma unroll 1
    for (int br = 0; br < 2; ++br) {
      f32x16 ga[2][1];
      acc_zero<1>(ga);
      gemm_core<1>(H, DM, m * 128, 0, TT, WL + W_GATE + (long)(br * 1024 + n0) * DM, DM, DM, ga);
#pragma unroll
      for (int i = 0; i < 2; ++i)
#pragma unroll
        for (int r = 0; r < 16; ++r) ga[i][0][r] = sigmoidf_(ga[i][0][r]);
      f32x16 ba[2][1];
      acc_zero<1>(ba);
      const int ycol = br == 0 ? C_AQ : C_BQ;
      gemm_core<1>(P + ycol, PC, m * 128, 0, TT, WL + W_BR + (long)br * 1024 * 512 + (long)n0 * 512, 512, 512, ba);
#pragma unroll
      for (int i = 0; i < 2; ++i)
#pragma unroll
        for (int r = 0; r < 16; ++r) mg[i][0][r] += ga[i][0][r] * ba[i][0][r];
    }
    acc_to_lds<1>(mg);
    store_bf16_tile<64>(part, PC);
    f32x16 gc[2][1];
    acc_zero<1>(gc);
    gemm_core<1>(H, DM, m * 128, 0, TT, WL + W_GATE + (long)(2 * 1024 + n0) * DM, DM, DM, gc);
#pragma unroll
    for (int i = 0; i < 2; ++i)
#pragma unroll
      for (int r = 0; r < 16; ++r) gc[i][0][r] = sigmoidf_(gc[i][0][r]);
    acc_to_lds<1>(gc);
    store_bf16_tile<64>(sigp, DM);
  } else {
    f32x16 ba[2][1];
    acc_zero<1>(ba);
    gemm_core<1>(P + C_CZ, PC, m * 128, 0, TT, WL + W_BR + 2L * 1024 * 512 + (long)n0 * 512, 512, 512, ba);
    acc_to_lds<1>(ba);
    const float* sC = (const float*)smem_raw;
    u16* outp = (u16*)(p.ws + OFF_M) + (long)(m * 128) * DM + n0;
#pragma unroll
    for (int i = 0; i < 4; ++i) {
      const int r = r0 + 32 * i;
      float4 x = *(const float4*)(sC + r * LDC + c);
      float4 y = *(const float4*)(sC + r * LDC + c + 4);
      const uint4 v = *(const uint4*)(part + (long)r * PC + c);
      const uint4 g = *(const uint4*)(sigp + (long)r * DM + c);
      x.x = lo16(v.x) + lo16(g.x) * x.x; x.y = hi16(v.x) + hi16(g.x) * x.y;
      x.z = lo16(v.y) + lo16(g.y) * x.z; x.w = hi16(v.y) + hi16(g.y) * x.w;
      y.x = lo16(v.z) + lo16(g.z) * y.x; y.y = hi16(v.z) + hi16(g.z) * y.y;
      y.z = lo16(v.w) + lo16(g.w) * y.z; y.w = hi16(v.w) + hi16(g.w) * y.w;
      uint4 o; o.x = pack2(x.x, x.y); o.y = pack2(x.z, x.w); o.z = pack2(y.x, y.y); o.w = pack2(y.z, y.w);
      *(uint4*)(outp + (long)r * DM + c) = o;
    }
  }
}

__device__ __forceinline__ void phase_merge(const Params& p, int layer) {
  (void)layer;
  for (int kk = 0;; ++kk) {
    const int id = xcd_linear(kk);
    if (kk * (int)gridDim.x >= 256 * 16) break;
    if (id >= 256 * 16) continue;
    int m, nq;
    tile_mn(id, 256, 16, m, nq);
    merge_tile(p, m, nq, 2);
  }
}

__device__ __forceinline__ void phase_gemm_f32(const u16* A, long lda, const u16* Wt, int K, u16* C) {
  for (int kk = 0;; ++kk) {
    const int id = xcd_linear(kk);
    if (kk * (int)gridDim.x >= 256 * 8) break;
    if (id >= 256 * 8) continue;
    int m, nq;
    tile_mn(id, 256, 8, m, nq);
    const int n0 = nq * 128;
    f32x16 acc[2][2];
    acc_zero<2>(acc);
    gemm_glds2(A, lda, m * 128, Wt + (long)n0 * K, K, K, acc);
    acc_to_lds<2>(acc);
    store_bf16_tile<128>(C + (long)(m * 128) * DM + n0, DM);
  }
}

__device__ __forceinline__ void phase_up(const Params& p, int layer) {
  const u16* H = (const u16*)(p.ws + OFF_H);
  const u16* W = (const u16*)(p.ws + OFF_WT) + W_UP;
  u16* ACT = (u16*)(p.ws + OFF_ACT);
  const int tid = tid_op();
  for (int kk = 0;; ++kk) {
    const int id = xcd_linear(kk);
    if (kk * (int)gridDim.x >= 262 * 44) break;
    if (id >= 262 * 44) continue;
    int mt, nb;
    tile_mn(id, 262, 44, mt, nb);
    const int b = mt / 131, tt = mt % 131;
    const int grow0 = b * SEQ + 126 * tt - 2;
    const int row_lo = b * SEQ, row_hi = (b + 1) * SEQ;
    f32x16 acc[2][2];
    acc_zero<2>(acc);
    if (grow0 >= row_lo && grow0 + 128 <= row_hi) gemm_glds2(H, DM, grow0, W + (long)(nb * 128) * DM, DM, DM, acc);
    else gemm_core<2, true>(H, DM, grow0, row_lo, row_hi, W + (long)(nb * 128) * DM, DM, DM, acc);
    acc_to_lds<2>(acc);
    const float* sC = (const float*)smem_raw;
    const int c = tid & 63, rg = tid >> 6;
    const float* fc = p.ffn_conv + (long)layer * 3 * 5632 + nb * 64 + c;
    const float g0 = fc[0], g1 = fc[5632], g2 = fc[2 * 5632];
    const float u0 = fc[DFF], u1 = fc[5632 + DFF], u2 = fc[2 * 5632 + DFF];
    const int rs = 2 + 32 * rg, re = min(rs + 32, 128);
    float ga = sC[(rs - 2) * LDC + c], gb = sC[(rs - 1) * LDC + c];
    float ua = sC[(rs - 2) * LDC + 64 + c], ub = sC[(rs - 1) * LDC + 64 + c];
    for (int r = rs; r < re; ++r) {
      const float gc = sC[r * LDC + c], uc = sC[r * LDC + 64 + c];
      const float fg = g0 * ga + g1 * gb + g2 * gc;
      const float fu = u0 * ua + u1 * ub + u2 * uc;
      const float t = 0.7978845608028654f * (fg + 0.044715f * fg * fg * fg);
      const float ge = fg / (1.f + __expf(-2.f * t));
      const int gr = grow0 + r;
      if (gr < row_hi) ACT[(long)gr * DFF + nb * 64 + c] = f2bf(ge * fu);
      ga = gb; gb = gc; ua = ub; ub = uc;
    }
  }
}

__device__ __forceinline__ bf16x8 pack8(const f32x16& v, int s) {
  typedef unsigned u32x4_ __attribute__((ext_vector_type(4)));
  u32x4_ r;
#pragma unroll
  for (int j = 0; j < 4; ++j) r[j] = pack2(v[8 * s + 2 * j], v[8 * s + 2 * j + 1]);
  return __builtin_bit_cast(bf16x8, r);
}
constexpr int ATT_LK = 72, ATT_LV = 136;
#define ATT_LOAD(KT, COLK, COLV)                                                            \
  {                                                                                         \
    const u16* kp_ = P + (rb + (long)(KT) * 128 + key_l) * PC + 32 * dq;                    \
    _Pragma("unroll") for (int i = 0; i < 4; ++i) {                                         \
      pk[i] = *(const v4u*)(kp_ + (COLK) + 8 * i);                                          \
      pv[i] = *(const v4u*)(kp_ + (COLV) + 8 * i);                                          \
    }                                                                                       \
  }
#define ATT_STORE()                                                                         \
  {                                                                                         \
    _Pragma("unroll") for (int i = 0; i < 4; ++i) *(v4u*)(sK + key_l * ATT_LK + 32 * dq + 8 * i) = pk[i]; \
    const int kpos_ = (key_l & ~12) | (((key_l >> 2) & 1) << 3) | (((key_l >> 3) & 1) << 2); \
    _Pragma("unroll") for (int i = 0; i < 4; ++i) {                                         \
      _Pragma("unroll") for (int e = 0; e < 4; ++e) {                                       \
        const unsigned w_ = pv[i][e];                                                       \
        sVT[(32 * dq + 8 * i + 2 * e) * ATT_LV + kpos_] = (u16)(w_ & 0xffffu);              \
        sVT[(32 * dq + 8 * i + 2 * e + 1) * ATT_LV + kpos_] = (u16)(w_ >> 16);              \
      }                                                                                     \
    }                                                                                       \
  }

__device__ __forceinline__ void sb_item(u16* P, int b, int hh, int qb) {
  const int tid = tid_op(), lane = tid & 63, wid = tid >> 6, fr = lane & 31, h5 = lane >> 5;
  u16* sK = (u16*)smem_raw;
  u16* sVT = sK + 128 * ATT_LK;
  const long rb = (long)b * SEQ;
  const int tq = qb * 128 + 32 * wid + fr;
  const float THR2 = -150.1f;
  bf16x8 qf[4];
  {
    const u16* qp = P + (rb + tq) * PC + C_AQ + hh * 64 + 8 * h5;
#pragma unroll
    for (int ks = 0; ks < 4; ++ks) qf[ks] = *(const bf16x8*)(qp + 16 * ks);
  }
  f32x16 oacc[2];
#pragma unroll
  for (int dt = 0; dt < 2; ++dt)
#pragma unroll
    for (int r = 0; r < 16; ++r) oacc[dt][r] = 0.f;
  float lrem = 0.f;
  const float qs = 0.125f * 1.4426950408889634f;
  const int key_l = tid & 127, dq = tid >> 7;
  v4u pk[4], pv[4];
  ATT_LOAD(qb, C_AK + hh * 64, C_AV + hh * 64);
  for (int kt = qb; kt >= 0; --kt) {
    __syncthreads();
    ATT_STORE();
    if (kt > 0) ATT_LOAD(kt - 1, C_AK + hh * 64, C_AV + hh * 64);
    __syncthreads();
    const bool diag = (kt == qb);
    if (__any(lrem > THR2)) {
#pragma unroll 1
      for (int st = diag ? wid : 3; st >= 0; --st) {
        f32x16 s;
#pragma unroll
        for (int r = 0; r < 16; ++r) s[r] = 0.f;
#pragma unroll
        for (int ks = 0; ks < 4; ++ks) {
          const bf16x8 a = *(const bf16x8*)(sK + (32 * st + fr) * ATT_LK + 16 * ks + 8 * h5);
          s = __builtin_amdgcn_mfma_f32_32x32x16_bf16(a, qf[ks], s, 0, 0, 0);
        }
        const bool mask_tile = diag && (st == wid);
        const int kbase = kt * 128 + 32 * st + 4 * h5;
        float ls[16];
#pragma unroll
        for (int r = 0; r < 16; ++r) {
          const float z = s[r] * qs;
          const float e = __builtin_amdgcn_exp2f(-fabsf(z));
          const float sp = fmaxf(z, 0.f) + __builtin_amdgcn_logf(1.f + e);
          const bool valid = !mask_tile || (kbase + 8 * (r >> 2) + (r & 3) < tq);
          ls[r] = valid ? -sp : 0.f;
          s[r] = valid ? z - sp : -INFINITY;
        }
        float G[4], Pg[4];
#pragma unroll
        for (int g = 0; g < 4; ++g) {
          G[g] = (ls[4 * g] + ls[4 * g + 1]) + (ls[4 * g + 2] + ls[4 * g + 3]);
          Pg[g] = __shfl_xor(G[g], 32);
        }
        const float T3 = G[3] + Pg[3], T2 = G[2] + Pg[2], T1 = G[1] + Pg[1], T0 = G[0] + Pg[0];
        float ab[4];
        ab[3] = lrem;
        ab[2] = lrem + T3;
        ab[1] = ab[2] + T2;
        ab[0] = ab[1] + T1;
        const float lnew = ab[0] + T0;
#pragma unroll
        for (int g = 0; g < 4; ++g) {
          float run = ab[g] + (h5 == 0 ? Pg[g] : 0.f);
#pragma unroll
          for (int e = 3; e >= 0; --e) {
            const float la = s[4 * g + e];
            s[4 * g + e] = __builtin_amdgcn_exp2f(la + run);
            run += ls[4 * g + e];
          }
        }
        lrem = lnew;
        const bf16x8 vb0 = pack8(s, 0), vb1 = pack8(s, 1);
#pragma unroll
        for (int dt = 0; dt < 2; ++dt) {
          const bf16x8 a0 = *(const bf16x8*)(sVT + (32 * dt + fr) * ATT_LV + 32 * st + 8 * h5);
          const bf16x8 a1 = *(const bf16x8*)(sVT + (32 * dt + fr) * ATT_LV + 32 * st + 16 + 8 * h5);
          oacc[dt] = __builtin_amdgcn_mfma_f32_32x32x16_bf16(a0, vb0, oacc[dt], 0, 0, 0);
          oacc[dt] = __builtin_amdgcn_mfma_f32_32x32x16_bf16(a1, vb1, oacc[dt], 0, 0, 0);
        }
      }
    }
    if (!__syncthreads_or(lrem > THR2)) break;
  }
  {
    u16* op = P + (rb + tq) * PC + C_AQ + hh * 64 + 4 * h5;
#pragma unroll
    for (int dt = 0; dt < 2; ++dt)
#pragma unroll
      for (int g = 0; g < 4; ++g) {
        uint2 o; o.x = pack2(oacc[dt][4 * g], oacc[dt][4 * g + 1]); o.y = pack2(oacc[dt][4 * g + 2], oacc[dt][4 * g + 3]);
        *(uint2*)(op + 32 * dt + 8 * g) = o;
      }
  }
}

__device__ __forceinline__ void swa_item(const Params& p, int layer, u16* P, int b, int qb, int hq) {
  const int tid = tid_op(), lane = tid & 63, wid = tid >> 6, fr = lane & 31, h5 = lane >> 5;
  u16* sK = (u16*)smem_raw;
  u16* sVT = sK + 128 * ATT_LK;
  const long rb = (long)b * SEQ;
  const int tq = qb * 128 + 32 * wid + fr;
  const int kvh = hq >> 2;
  const float L2E = 1.4426950408889634f;
  const float qs = 0.125f * L2E;
  const float slope2 = exp2f(-(float)(hq + 1)) * L2E;
  bf16x8 qf[4];
  u16* qp = P + (rb + tq) * PC + C_BQ + hq * 64;
#pragma unroll
  for (int ks = 0; ks < 4; ++ks) qf[ks] = *(const bf16x8*)(qp + 8 * h5 + 16 * ks);
  f32x16 oacc[2];
#pragma unroll
  for (int dt = 0; dt < 2; ++dt)
#pragma unroll
    for (int r = 0; r < 16; ++r) oacc[dt][r] = 0.f;
  float m = p.sw_sinks[layer * 8 + hq] * L2E;
  float l = (h5 == 0) ? 1.f : 0.f;
  const int key_l = tid & 127, dq = tid >> 7;
  v4u pk[4], pv[4];
  ATT_LOAD(qb, C_BK + kvh * 64, C_BV + kvh * 64);
  for (int kt = qb; kt >= 0 && kt >= qb - 1; --kt) {
    __syncthreads();
    ATT_STORE();
    if (kt == qb && kt > 0) ATT_LOAD(kt - 1, C_BK + kvh * 64, C_BV + kvh * 64);
    __syncthreads();
    const bool diag = (kt == qb);
    const int st_hi = diag ? wid : 3, st_lo = diag ? 0 : wid;
#pragma unroll 1
    for (int st = st_hi; st >= st_lo; --st) {
      f32x16 s;
#pragma unroll
      for (int r = 0; r < 16; ++r) s[r] = 0.f;
#pragma unroll
      for (int ks = 0; ks < 4; ++ks) {
        const bf16x8 a = *(const bf16x8*)(sK + (32 * st + fr) * ATT_LK + 16 * ks + 8 * h5);
        s = __builtin_amdgcn_mfma_f32_32x32x16_bf16(a, qf[ks], s, 0, 0, 0);
      }
      const int kbase = kt * 128 + 32 * st + 4 * h5;
      float mx = m;
#pragma unroll
      for (int r = 0; r < 16; ++r) {
        const int dist = tq - (kbase + 8 * (r >> 2) + (r & 3));
        const bool valid = (dist >= 0) && (dist < 128);
        s[r] = valid ? s[r] * qs - slope2 * (float)dist : -INFINITY;
        mx = fmaxf(mx, s[r]);
      }
      mx = fmaxf(mx, __shfl_xor(mx, 32));
      const float corr = __builtin_amdgcn_exp2f(m - mx);
      m = mx;
      float ps = 0.f;
#pragma unroll
      for (int r = 0; r < 16; ++r) {
        s[r] = __builtin_amdgcn_exp2f(s[r] - mx);
        ps += s[r];
      }
      l = l * corr + ps;
#pragma unroll
      for (int dt = 0; dt < 2; ++dt)
#pragma unroll
        for (int r = 0; r < 16; ++r) oacc[dt][r] *= corr;
      const bf16x8 vb0 = pack8(s, 0), vb1 = pack8(s, 1);
#pragma unroll
      for (int dt = 0; dt < 2; ++dt) {
        const bf16x8 a0 = *(const bf16x8*)(sVT + (32 * dt + fr) * ATT_LV + 32 * st + 8 * h5);
        const bf16x8 a1 = *(const bf16x8*)(sVT + (32 * dt + fr) * ATT_LV + 32 * st + 16 + 8 * h5);
        oacc[dt] = __builtin_amdgcn_mfma_f32_32x32x16_bf16(a0, vb0, oacc[dt], 0, 0, 0);
        oacc[dt] = __builtin_amdgcn_mfma_f32_32x32x16_bf16(a1, vb1, oacc[dt], 0, 0, 0);
      }
    }
  }
  l += __shfl_xor(l, 32);
  const float inv = 1.f / l;
#pragma unroll
  for (int dt = 0; dt < 2; ++dt)
#pragma unroll
    for (int g = 0; g < 4; ++g) {
      uint2 o;
      o.x = pack2(oacc[dt][4 * g] * inv, oacc[dt][4 * g + 1] * inv);
      o.y = pack2(oacc[dt][4 * g + 2] * inv, oacc[dt][4 * g + 3] * inv);
      *(uint2*)(qp + 4 * h5 + 32 * dt + 8 * g) = o;
    }
}

__device__ __forceinline__ int permg(int g) { return (g & ~3) | ((g & 1) << 1) | ((g >> 1) & 1); }

__device__ __forceinline__ void gdn_prep_item(const Params& p, u16* P, int b, int h, int n) {
  const int tid = tid_op(), lane = tid & 63, wid = tid >> 6, fr = lane & 31, h5 = lane >> 5, fh = h5 * 8;
  u16* sK = (u16*)smem_raw;
  u16* sQ = sK + 64 * 136;
  u16* sVT = sQ + 64 * 136;
  u16* sKT = sVT + 128 * 72;
  float* sGc = (float*)(sKT + 128 * 72);
  float* sEg = sGc + 64;
  float* sEgl = sGc + 128;
  float* sBe = sGc + 192;
  const long row0 = (long)b * SEQ + n * 64;
  const int ci = (b * 4 + h) * 256 + n;
  u16* kdT = (u16*)(p.ws + OFF_M) + (long)ci * 12288;
  u16* aout = kdT + 8192;
  const float* G = (const float*)(p.ws + OFF_G);
  const float* BT = (const float*)(p.ws + OFF_BETA);
  const float scale = 0.08838834764831845f;
  __syncthreads();
  if (wid == 0) {
    float g = G[(row0 + lane) * 4 + h];
#pragma unroll
    for (int o = 1; o < 64; o <<= 1) { const float t = __shfl_up(g, o); if (lane >= o) g += t; }
    const float glast = __shfl(g, 63);
    sGc[lane] = g; sEg[lane] = __expf(g); sEgl[lane] = __expf(glast - g); sBe[lane] = BT[(row0 + lane) * 4 + h];
    if (lane == 63) ((float*)(p.ws + OFF_GL))[ci] = __expf(g);
  }
#pragma unroll
  for (int i = 0; i < 4; ++i) {
    const int ch = tid + 256 * i, r = ch >> 4, c = (ch & 15) * 8;
    const u16* src = P + (row0 + r) * PC + h * 128 + c;
    *(uint4*)(sQ + r * 136 + c) = *(const uint4*)(src + C_CQ);
    *(uint4*)(sK + r * 136 + c) = *(const uint4*)(src + C_CK);
  }
  __syncthreads();
  const int bi = wid >> 1, bj = wid & 1;
  f32x16 kk, qk;
#pragma unroll
  for (int r = 0; r < 16; ++r) { kk[r] = 0.f; qk[r] = 0.f; }
  if (!(bi == 0 && bj == 1)) {
#pragma unroll
    for (int ks = 0; ks < 8; ++ks) {
      const bf16x8 ak = *(const bf16x8*)(sK + (32 * bi + fr) * 136 + ks * 16 + fh);
      const bf16x8 aq = *(const bf16x8*)(sQ + (32 * bi + fr) * 136 + ks * 16 + fh);
      const bf16x8 bk = *(const bf16x8*)(sK + (32 * bj + fr) * 136 + ks * 16 + fh);
      kk = __builtin_amdgcn_mfma_f32_32x32x16_bf16(ak, bk, kk, 0, 0, 0);
      qk = __builtin_amdgcn_mfma_f32_32x32x16_bf16(aq, bk, qk, 0, 0, 0);
    }
  }
#pragma unroll
  for (int i = 0; i < 8; ++i) {
    const int gi = tid + 256 * i, r = gi >> 5, g = gi & 31;
    const uint2 v = *(const uint2*)(sQ + r * 136 + 4 * g);
    const float f = scale * sEg[r];
    uint2 o; o.x = pack2(lo16(v.x) * f, hi16(v.x) * f); o.y = pack2(lo16(v.y) * f, hi16(v.y) * f);
    *(uint2*)(P + (row0 + r) * PC + C_CQ + h * 128 + 4 * permg(g)) = o;
  }
#pragma unroll
  for (int i = 0; i < 8; ++i) {
    const int gi = tid + 256 * i, dk = gi & 127, tg = gi >> 7;
    float kd[4], kb[4];
#pragma unroll
    for (int e = 0; e < 4; ++e) {
      const float kv = bf2f(sK[(4 * tg + e) * 136 + dk]);
      kd[e] = kv * sEgl[4 * tg + e];
      kb[e] = kv * sBe[4 * tg + e] * sEg[4 * tg + e];
    }
    uint2 o; o.x = pack2(kd[0], kd[1]); o.y = pack2(kd[2], kd[3]);
    *(uint2*)(kdT + dk * 64 + 4 * permg(tg)) = o;
    uint2 o2; o2.x = pack2(kb[0], kb[1]); o2.y = pack2(kb[2], kb[3]);
    *(uint2*)(sKT + dk * 72 + 4 * tg) = o2;
  }
#pragma unroll
  for (int i = 0; i < 4; ++i) {
    const int ch = tid + 256 * i, r = ch >> 4, c = (ch & 15) * 8;
    const uint4 v = *(const uint4*)(P + (row0 + r) * PC + C_CV + h * 128 + c);
    const float be = sBe[r];
    sVT[(c + 0) * 72 + r] = f2bf(lo16(v.x) * be); sVT[(c + 1) * 72 + r] = f2bf(hi16(v.x) * be);
    sVT[(c + 2) * 72 + r] = f2bf(lo16(v.y) * be); sVT[(c + 3) * 72 + r] = f2bf(hi16(v.y) * be);
    sVT[(c + 4) * 72 + r] = f2bf(lo16(v.z) * be); sVT[(c + 5) * 72 + r] = f2bf(hi16(v.z) * be);
    sVT[(c + 6) * 72 + r] = f2bf(lo16(v.w) * be); sVT[(c + 7) * 72 + r] = f2bf(hi16(v.w) * be);
  }
  __syncthreads();
  float* sL = (float*)sQ;
  u16* sA = sK;
  u16* sT = sK + 64 * 64;
#pragma unroll
  for (int r = 0; r < 16; ++r) {
    const int i = 32 * bi + (r & 3) + 8 * (r >> 2) + 4 * h5, j = 32 * bj + fr;
    const float dec = (i >= j) ? __expf(sGc[i] - sGc[j]) : 0.f;
    sL[i * 68 + j] = (i > j) ? sBe[i] * kk[r] * dec : 0.f;
    sA[i * 64 + j] = f2bf((i >= j) ? scale * qk[r] * dec : 0.f);
  }
  __syncthreads();
  if (wid == 0) {
    float t[64];
#pragma unroll
    for (int i = 0; i < 64; ++i) {
      float s = (i == lane) ? 1.f : 0.f;
#pragma unroll
      for (int j = 0; j < i; ++j) s -= sL[i * 68 + j] * t[j];
      t[i] = s;
      sT[i * 72 + lane] = f2bf(s);
    }
  } else {
    for (int g = tid - 64; g < 1024; g += 192) {
      const int r = g >> 4, gg = g & 15;
      *(uint2*)(aout + r * 64 + 4 * permg(gg)) = *(const uint2*)(sA + r * 64 + 4 * gg);
    }
  }
  __syncthreads();
  f32x16 ua[2], wa[2];
#pragma unroll
  for (int mi = 0; mi < 2; ++mi)
#pragma unroll
    for (int r = 0; r < 16; ++r) { ua[mi][r] = 0.f; wa[mi][r] = 0.f; }
#pragma unroll
  for (int ks = 0; ks < 4; ++ks) {
    const bf16x8 bu = *(const bf16x8*)(sVT + (32 * wid + fr) * 72 + ks * 16 + fh);
    const bf16x8 bw = *(const bf16x8*)(sKT + (32 * wid + fr) * 72 + ks * 16 + fh);
#pragma unroll
    for (int mi = 0; mi < 2; ++mi) {
      const bf16x8 at = *(const bf16x8*)(sT + (32 * mi + fr) * 72 + ks * 16 + fh);
      ua[mi] = __builtin_amdgcn_mfma_f32_32x32x16_bf16(at, bu, ua[mi], 0, 0, 0);
      wa[mi] = __builtin_amdgcn_mfma_f32_32x32x16_bf16(at, bw, wa[mi], 0, 0, 0);
    }
  }
  u16* sWs = sQ;
  {
    const int dv = 32 * wid + fr;
    u16* ub = P + (row0 + (dv >> 1)) * PC + C_CV + h * 128 + (dv & 1) * 64;
#pragma unroll
    for (int mi = 0; mi < 2; ++mi) {
#pragma unroll
      for (int q = 0; q < 4; ++q) {
        uint2 o; o.x = pack2(ua[mi][4 * q], ua[mi][4 * q + 1]); o.y = pack2(ua[mi][4 * q + 2], ua[mi][4 * q + 3]);
        *(uint2*)(ub + 32 * mi + 8 * q + 4 * h5) = o;
      }
#pragma unroll
      for (int r = 0; r < 16; ++r) {
        const int i = 32 * mi + (r & 3) + 8 * (r >> 2) + 4 * h5;
        sWs[i * 136 + dv] = f2bf(wa[mi][r]);
      }
    }
  }
  __syncthreads();
#pragma unroll
  for (int i = 0; i < 8; ++i) {
    const int gi = tid + 256 * i, r = gi >> 5, g = gi & 31;
    *(uint2*)(P + (row0 + r) * PC + C_CK + h * 128 + 4 * permg(g)) = *(const uint2*)(sWs + r * 136 + 4 * g);
  }
}

__device__ __forceinline__ void gdn_scan_item(const Params& p, u16* P, int b, int h) {
  const int tid0 = tid_op();
  u16* sW = (u16*)smem_raw;
  u16* sQd = sW + 64 * 136;
  u16* sKd = sQd + 64 * 136;
  u16* sAa = sKd + 128 * 72;
  const u16* MB = (const u16*)(p.ws + OFF_M) + (long)((b * 4 + h) * 256) * 12288;
  const float* GL = (const float*)(p.ws + OFF_GL) + (b * 4 + h) * 256;
  f32x16 S[4];
#pragma unroll
  for (int kt = 0; kt < 4; ++kt)
#pragma unroll
    for (int r = 0; r < 16; ++r) S[kt][r] = 0.f;
  v4u rw[4], rq[4], rk[4], ra[2];
  v2u ru[8];
  float gl_next;
#define GDN_ISSUE_A(NN)                                                                               \
  {                                                                                                   \
    const long row0_ = (long)b * SEQ + (NN) * 64;                                                     \
    _Pragma("unroll") for (int i = 0; i < 4; ++i) {                                                   \
      const int ch = tid + 256 * i, r = ch >> 4, c = (ch & 15) * 8;                                   \
      const u16* src = P + (row0_ + r) * PC + h * 128 + c;                                            \
      rw[i] = *(const v4u*)(src + C_CK);                                                              \
      rq[i] = *(const v4u*)(src + C_CQ);                                                              \
    }                                                                                                 \
  }
#define GDN_ISSUE_B(NN)                                                                               \
  {                                                                                                   \
    const u16* mb = MB + (long)(NN) * 12288;                                                          \
    _Pragma("unroll") for (int i = 0; i < 4; ++i) rk[i] = *(const v4u*)(mb + (tid + 256 * i) * 8);    \
    _Pragma("unroll") for (int i = 0; i < 2; ++i) ra[i] = *(const v4u*)(mb + 8192 + (tid + 256 * i) * 8); \
  }
#define GDN_ISSUE_U(NN)                                                                               \
  {                                                                                                   \
    const u16* ub = P + ((long)b * SEQ + (NN) * 64 + (dv >> 1)) * PC + C_CV + h * 128 + (dv & 1) * 64 + 4 * h5; \
    _Pragma("unroll") for (int i = 0; i < 8; ++i) ru[i] = *(const v2u*)(ub + 8 * i);                  \
  }
  {
    const int tid = tid0, lane = tid & 63, wid = tid >> 6, fr = lane & 31, h5 = lane >> 5, dv = 32 * wid + fr;
    GDN_ISSUE_A(0);
    GDN_ISSUE_B(0);
    GDN_ISSUE_U(0);
    gl_next = GL[0];
  }
  for (int n = 0; n < 256; ++n) {
    const long row0 = (long)b * SEQ + n * 64;
    const int nn = (n + 1 < 256) ? n + 1 : 255;
    int tl_ = tid0;
    asm volatile("" : "+v"(tl_));
    const int tid = tl_, lane = tid & 63, wid = tid >> 6, fr = lane & 31, h5 = lane >> 5, fh = h5 * 8, dv = 32 * wid + fr;
    lds_barrier();
#pragma unroll
    for (int i = 0; i < 4; ++i) {
      const int ch = tid + 256 * i, r = ch >> 4, c = (ch & 15) * 8;
      *(v4u*)(sW + r * 136 + c) = rw[i];
      *(v4u*)(sQd + r * 136 + c) = rq[i];
      const int r2 = ch >> 3, c2 = (ch & 7) * 8;
      *(v4u*)(sKd + r2 * 72 + c2) = rk[i];
    }
#pragma unroll
    for (int i = 0; i < 2; ++i) {
      const int ch = tid + 256 * i, r2 = ch >> 3, c2 = (ch & 7) * 8;
      *(v4u*)(sAa + r2 * 72 + c2) = ra[i];
    }
    const float gl = gl_next;
    gl_next = GL[nn];
    lds_barrier();
    f32x16 vn[2];
#pragma unroll
    for (int mi = 0; mi < 2; ++mi)
#pragma unroll
      for (int r = 0; r < 16; ++r) vn[mi][r] = 0.f;
    {
      bf16x8 fa[2][2];
#pragma unroll
      for (int mi = 0; mi < 2; ++mi) fa[0][mi] = *(const bf16x8*)(sW + (32 * mi + fr) * 136 + fh);
      const long rown_ = (long)b * SEQ + nn * 64;
      const u16* mbn_ = MB + (long)nn * 12288;
#pragma unroll
      for (int it = 0; it < 8; ++it) {
        if (it + 1 < 8) {
#pragma unroll
          for (int mi = 0; mi < 2; ++mi) fa[(it + 1) & 1][mi] = *(const bf16x8*)(sW + (32 * mi + fr) * 136 + 16 * (it + 1) + fh);
        }
        if (it < 4) {
          const int ch = tid + 256 * it, r = ch >> 4, c = (ch & 15) * 8;
          const u16* src = P + (rown_ + r) * PC + h * 128 + c;
          rw[it] = *(const v4u*)(src + C_CK);
          rq[it] = *(const v4u*)(src + C_CQ);
        } else {
          rk[it - 4] = *(const v4u*)(mbn_ + (tid + 256 * (it - 4)) * 8);
          if (it < 6) ra[it - 4] = *(const v4u*)(mbn_ + 8192 + (tid + 256 * (it - 4)) * 8);
        }
        __builtin_amdgcn_sched_barrier(0);
        const bf16x8 sb = pack8(S[it >> 1], it & 1);
#pragma unroll
        for (int mi = 0; mi < 2; ++mi) vn[mi] = __builtin_amdgcn_mfma_f32_32x32x16_bf16(fa[it & 1][mi], sb, vn[mi], 0, 0, 0);
        __builtin_amdgcn_sched_barrier(0);
      }
    }
#pragma unroll
    for (int mi = 0; mi < 2; ++mi)
#pragma unroll
      for (int q = 0; q < 4; ++q) {
        const v2u u2 = ru[mi * 4 + q];
        vn[mi][4 * q + 0] = lo16(u2.x) - vn[mi][4 * q + 0];
        vn[mi][4 * q + 1] = hi16(u2.x) - vn[mi][4 * q + 1];
        vn[mi][4 * q + 2] = lo16(u2.y) - vn[mi][4 * q + 2];
        vn[mi][4 * q + 3] = hi16(u2.y) - vn[mi][4 * q + 3];
      }
    bf16x8 vb[2][2];
#pragma unroll
    for (int mi = 0; mi < 2; ++mi)
#pragma unroll
      for (int s = 0; s < 2; ++s) vb[mi][s] = pack8(vn[mi], s);
    __builtin_amdgcn_sched_barrier(0);
    {
      f32x16 oo[2];
#pragma unroll
      for (int mi = 0; mi < 2; ++mi)
#pragma unroll
        for (int r = 0; r < 16; ++r) oo[mi][r] = 0.f;
      bf16x8 fa[2][2];
#pragma unroll
      for (int mi = 0; mi < 2; ++mi) fa[0][mi] = *(const bf16x8*)(sQd + (32 * mi + fr) * 136 + fh);
#pragma unroll
      for (int it = 0; it < 12; ++it) {
        if (it + 1 < 8) {
#pragma unroll
          for (int mi = 0; mi < 2; ++mi) fa[(it + 1) & 1][mi] = *(const bf16x8*)(sQd + (32 * mi + fr) * 136 + 16 * (it + 1) + fh);
        } else if (it + 1 < 12) {
          const int j = it + 1 - 8;
#pragma unroll
          for (int s = 0; s < 2; ++s) fa[(it + 1) & 1][s] = *(const bf16x8*)(sAa + (32 * (j >> 1) + fr) * 72 + 32 * (j & 1) + 16 * s + fh);
        }
        __builtin_amdgcn_sched_barrier(0);
        if (it < 8) {
          const bf16x8 sb = pack8(S[it >> 1], it & 1);
#pragma unroll
          for (int mi = 0; mi < 2; ++mi) oo[mi] = __builtin_amdgcn_mfma_f32_32x32x16_bf16(fa[it & 1][mi], sb, oo[mi], 0, 0, 0);
        } else {
          const int j = it - 8;
#pragma unroll
          for (int s = 0; s < 2; ++s) oo[j >> 1] = __builtin_amdgcn_mfma_f32_32x32x16_bf16(fa[it & 1][s], vb[j & 1][s], oo[j >> 1], 0, 0, 0);
        }
        __builtin_amdgcn_sched_barrier(0);
      }
      u16* ob = P + (row0 + (dv >> 1)) * PC + C_CV + h * 128 + (dv & 1) * 64 + 4 * h5;
#pragma unroll
      for (int mi = 0; mi < 2; ++mi)
#pragma unroll
        for (int q = 0; q < 4; ++q) {
          uint2 o; o.x = pack2(oo[mi][4 * q], oo[mi][4 * q + 1]); o.y = pack2(oo[mi][4 * q + 2], oo[mi][4 * q + 3]);
          *(uint2*)(ob + 32 * mi + 8 * q) = o;
        }
    }
    __builtin_amdgcn_sched_barrier(0);
    {
      bf16x8 fa[2][2];
#pragma unroll
      for (int s = 0; s < 2; ++s) fa[0][s] = *(const bf16x8*)(sKd + fr * 72 + 16 * s + fh);
#pragma unroll
      for (int it = 0; it < 8; ++it) {
        if (it + 1 < 8) {
#pragma unroll
          for (int s = 0; s < 2; ++s)
            fa[(it + 1) & 1][s] = *(const bf16x8*)(sKd + (32 * ((it + 1) >> 1) + fr) * 72 + 32 * ((it + 1) & 1) + 16 * s + fh);
        }
        __builtin_amdgcn_sched_barrier(0);
        if ((it & 1) == 0) {
#pragma unroll
          for (int r = 0; r < 16; ++r) S[it >> 1][r] *= gl;
        }
#pragma unroll
        for (int s = 0; s < 2; ++s) S[it >> 1] = __builtin_amdgcn_mfma_f32_32x32x16_bf16(fa[it & 1][s], vb[it & 1][s], S[it >> 1], 0, 0, 0);
        __builtin_amdgcn_sched_barrier(0);
      }
    }
    GDN_ISSUE_U(nn);
  }
#undef GDN_ISSUE_A
#undef GDN_ISSUE_B
#undef GDN_ISSUE_U
}

__device__ __forceinline__ void gdn_post_item(const Params& p, int layer, u16* P, int b, int h, int n) {
  const int tid = tid_op();
  u16* sO = (u16*)smem_raw;
  const long row0 = (long)b * SEQ + n * 64;
  const float* gnp = p.gdn_norm + layer * 128;
  __syncthreads();
#pragma unroll
  for (int i = 0; i < 4; ++i) {
    const int ch = tid + 256 * i, r2 = ch >> 4, c = (ch & 15) * 8;
    const uint4 v = *(const uint4*)(P + (row0 + r2) * PC + C_CV + h * 128 + c);
    const int dvv = 2 * r2 + (c >> 6), tok = c & 63;
    sO[(tok + 0) * 136 + dvv] = (u16)(v.x & 0xffffu); sO[(tok + 1) * 136 + dvv] = (u16)(v.x >> 16);
    sO[(tok + 2) * 136 + dvv] = (u16)(v.y & 0xffffu); sO[(tok + 3) * 136 + dvv] = (u16)(v.y >> 16);
    sO[(tok + 4) * 136 + dvv] = (u16)(v.z & 0xffffu); sO[(tok + 5) * 136 + dvv] = (u16)(v.z >> 16);
    sO[(tok + 6) * 136 + dvv] = (u16)(v.w & 0xffffu); sO[(tok + 7) * 136 + dvv] = (u16)(v.w >> 16);
  }
  __syncthreads();
  const int r = tid >> 2, cq = (tid & 3) * 32;
  float ss = 0.f;
#pragma unroll
  for (int i = 0; i < 4; ++i) {
    const uint4 v = *(const uint4*)(sO + r * 136 + cq + 8 * i);
    ss += lo16(v.x) * lo16(v.x) + hi16(v.x) * hi16(v.x) + lo16(v.y) * lo16(v.y) + hi16(v.y) * hi16(v.y) +
          lo16(v.z) * lo16(v.z) + hi16(v.z) * hi16(v.z) + lo16(v.w) * lo16(v.w) + hi16(v.w) * hi16(v.w);
  }
  ss += __shfl_xor(ss, 1);
  ss += __shfl_xor(ss, 2);
  const float rs = rsqrtf(ss * (1.f / 128.f) + 1e-6f);
  u16* zp = P + (row0 + r) * PC + C_CZ + h * 128 + cq;
#pragma unroll
  for (int i = 0; i < 4; ++i) {
    const uint4 zz = *(const uint4*)(zp + 8 * i);
    const uint4 vv = *(const uint4*)(sO + r * 136 + cq + 8 * i);
    const float ov[8] = {lo16(vv.x), hi16(vv.x), lo16(vv.y), hi16(vv.y), lo16(vv.z), hi16(vv.z), lo16(vv.w), hi16(vv.w)};
    const float4 g0 = *(const float4*)(gnp + cq + 8 * i);
    const float4 g1 = *(const float4*)(gnp + cq + 8 * i + 4);
    const float z[8] = {lo16(zz.x), hi16(zz.x), lo16(zz.y), hi16(zz.y), lo16(zz.z), hi16(zz.z), lo16(zz.w), hi16(zz.w)};
    const float gg[8] = {g0.x, g0.y, g0.z, g0.w, g1.x, g1.y, g1.z, g1.w};
    float y[8];
#pragma unroll
    for (int e = 0; e < 8; ++e) y[e] = ov[e] * rs * gg[e] * (z[e] * sigmoidf_(z[e]));
    uint4 o; o.x = pack2(y[0], y[1]); o.y = pack2(y[2], y[3]); o.z = pack2(y[4], y[5]); o.w = pack2(y[6], y[7]);
    *(uint4*)(zp + 8 * i) = o;
  }
}

__device__ __forceinline__ void phase_mixers(const Params& p, int layer, int part) {
  u16* P = (u16*)(p.ws + OFF_R);
  __shared__ int s_item;
  if (part == 0) {
    unsigned* cnt = (unsigned*)(p.ws + OFF_CNT) + layer;
    for (;;) {
      __syncthreads();
      if (tid_op() == 0) s_item = (int)atomicAdd(cnt, 1u);
      __syncthreads();
      const int it = s_item;
      if (it >= 6144) break;
      if (it < 2048) {
        gdn_prep_item(p, P, it >> 10, (it >> 8) & 3, it & 255);
      } else if (it < 4096) {
        const int k = it - 2048;
        const int qb = 127 - (k >> 4), bh = k & 15;
        sb_item(P, bh >> 3, bh & 7, qb);
      } else {
        const int k = it - 4096;
        swa_item(p, layer, P, k >> 10, (k >> 3) & 127, k & 7);
      }
    }
  } else {
    if (bid_op() < 8) gdn_scan_item(p, P, bid_op() >> 2, bid_op() & 3);
    const int xcd = bid_op() & 7;
    unsigned* cnt = (unsigned*)(p.ws + OFF_CNT) + 8 + layer * 8 + xcd;
    const int nb_ = bid_op() - (int)(gridDim.x >> 1);
    if (gridDim.x > 256 && nb_ >= 0 && nb_ < 8) return;
    for (;;) {
      __syncthreads();
      if (tid_op() == 0) s_item = (int)atomicAdd(cnt, 1u);
      __syncthreads();
      const int idx = s_item;
      if (idx >= 512) break;
      const int L = (((idx >> 6) << 3) + xcd) * 64 + (idx & 63);
      int m, nq;
      tile_mn(L, 256, 16, m, nq);
      merge_tile(p, m, nq, 1);
    }
  }
}

__device__ __forceinline__ void phase_gdn_post(const Params& p, int layer) {
  u16* P = (u16*)(p.ws + OFF_R);
  for (int it = bid_op(); it < 2048; it += gridDim.x) gdn_post_item(p, layer, P, it >> 10, (it >> 8) & 3, it & 255);
}

__device__ __forceinline__ void phase_prep(const Params& p) {
  if (bid_op() == 0 && tid_op() < 32) ((unsigned*)(p.ws + OFF_CNT))[tid_op()] = 0u;
  for (int j = bid_op(); j < 4608; j += gridDim.x) transpose_job(p, j);
  rownorm_phase(p, 0, nullptr, nullptr, p.ln_mix_pre, 0);
}

constexpr int N_PHASES = 1 + 10 * DEPTH;

__global__ void __launch_bounds__(256, 2) mega(Params p, int ph_lo, int ph_hi) {
  cg::grid_group grid = cg::this_grid();
  int ph = 0;
#define STEP(CALL)                                   \
  {                                                  \
    if (ph >= ph_lo && ph < ph_hi) {                 \
      if (ph > ph_lo) grid.sync();                   \
      CALL;                                          \
    }                                                \
    ++ph;                                            \
  }
  STEP(phase_prep(p));
#pragma unroll 1
  for (int layer = 0; layer < DEPTH; ++layer) {
    const u16* WL = (const u16*)(p.ws + OFF_WT);
    STEP(phase_inproj(p, layer));
    STEP(phase_mixers(p, layer, 0));
    STEP(phase_mixers(p, layer, 1));
    STEP(phase_gdn_post(p, layer));
    STEP(phase_merge(p, layer));
    STEP(phase_gemm_f32((const u16*)(p.ws + OFF_M), DM, WL + W_OUT, DM, (u16*)(p.ws + OFF_OUTF)));
    STEP(rownorm_phase(p, 1, (const u16*)(p.ws + OFF_OUTF), p.ln_mix_post + layer * DM, p.ln_ffn_pre + layer * DM, -1));
    STEP(phase_up(p, layer));
    STEP(phase_gemm_f32((const u16*)(p.ws + OFF_ACT), DFF, WL + W_DOWN, DFF, (u16*)(p.ws + OFF_OUTF2)));
    if (layer + 1 < DEPTH) {
      STEP(for (int j = bid_op(); j < 4608; j += gridDim.x) transpose_job(p, (layer + 1) * 4608 + j);
           rownorm_phase(p, 1, (const u16*)(p.ws + OFF_OUTF2), p.ln_ffn_post + layer * DM, p.ln_mix_pre + (layer + 1) * DM, layer + 1));
    } else {
      STEP(rownorm_phase(p, 1, (const u16*)(p.ws + OFF_OUTF2), p.ln_ffn_post + layer * DM, nullptr, -1));
    }
  }
#undef STEP
}

extern "C" void kernel_launch(void* const* d_in, const int* in_sizes, int n_in, void* d_out, int out_size, void* d_ws,
                              size_t ws_size, hipStream_t stream) {
  (void)in_sizes; (void)n_in; (void)out_size;
  if (ws_size < WS_NEED) { fprintf(stderr, "workspace too small: %zu < %zu\n", ws_size, (size_t)WS_NEED); return; }
  Params p{};
  p.x = (const float*)d_in[0]; p.ln_mix_pre = (const float*)d_in[1]; p.w_in = (const float*)d_in[2];
  p.sw_sinks = (const float*)d_in[3]; p.gdn_conv = (const float*)d_in[4]; p.gdn_a_log = (const float*)d_in[5];
  p.gdn_dt_bias = (const float*)d_in[6]; p.gdn_norm = (const float*)d_in[7]; p.w_br[0] = (const float*)d_in[8];
  p.w_br[1] = (const float*)d_in[9]; p.w_br[2] = (const float*)d_in[10]; p.w_out = (const float*)d_in[11];
  p.ln_mix_post = (const float*)d_in[12]; p.ln_ffn_pre = (const float*)d_in[13]; p.w_up = (const float*)d_in[14];
  p.ffn_conv = (const float*)d_in[15]; p.w_down = (const float*)d_in[16]; p.ln_ffn_post = (const float*)d_in[17];
  p.out = (float*)d_out; p.ws = (unsigned char*)d_ws;
  static int grid_blocks = 0;
  if (!grid_blocks) {
    int dev = 0, cus = 0, per_cu = 0;
    hipGetDevice(&dev);
    hipDeviceGetAttribute(&cus, hipDeviceAttributeMultiprocessorCount, dev);
    hipOccupancyMaxActiveBlocksPerMultiprocessor(&per_cu, mega, 256, 0);
    if (per_cu < 1) per_cu = 1;
    if (per_cu > 2) per_cu = 2;
    grid_blocks = cus * per_cu;
  }
#if MULTI_LAUNCH
  for (int ph = 0; ph < N_PHASES; ++ph) {
    int lo = ph, hi = ph + 1;
    void* args[] = {&p, &lo, &hi};
    hipError_t e = hipLaunchCooperativeKernel((void*)mega, dim3(grid_blocks), dim3(256), args, 0, stream);
    if (e != hipSuccess) fprintf(stderr, "launch failed: %s (grid %d)\n", hipGetErrorString(e), grid_blocks);
  }
#else
  int lo = 0, hi = N_PHASES;
  void* args[] = {&p, &lo, &hi};
  hipError_t e = hipLaunchCooperativeKernel((void*)mega, dim3(grid_blocks), dim3(256), args, 0, stream);
  if (e != hipSuccess) fprintf(stderr, "cooperative launch failed: %s (grid %d)\n", hipGetErrorString(e), grid_blocks);
#endif
}
```

```cpp
#include <hip/hip_runtime.h>
#include <hip/hip_bf16.h>
#include <hip/hip_cooperative_groups.h>
#include <cstdio>
namespace cg = cooperative_groups;

#ifndef MULTI_LAUNCH
#define MULTI_LAUNCH 0
#endif

typedef unsigned short u16;
using bf16x8 = __attribute__((ext_vector_type(8))) short;
using f32x16 = __attribute__((ext_vector_type(16))) float;
using v4u = __attribute__((ext_vector_type(4))) unsigned;
using v2u = __attribute__((ext_vector_type(2))) unsigned;

constexpr int SEQ = 16384;
constexpr int NB = 2;
constexpr int TT = NB * SEQ;
constexpr int DM = 1024;
constexpr int INC = 7432;
constexpr int PC = 4352;
constexpr int DFF = 2816;
constexpr int DEPTH = 2;
constexpr int C_AQ = 0, C_AK = 512, C_AV = 1024, C_BQ = 1536, C_BK = 2048, C_BV = 2176, C_CQ = 2304, C_CK = 2816,
              C_CV = 3328, C_CZ = 3840;
constexpr long W_IN = 0;
constexpr long W_GATE = W_IN + 4352L * 1024;
constexpr long W_BR = W_GATE + 3072L * 1024;
constexpr long W_OUT = W_BR + 3L * 1024 * 512;
constexpr long W_UP = W_OUT + 1024L * 1024;
constexpr long W_DOWN = W_UP + 5632L * 1024;
constexpr long W_LAYER = W_DOWN + 1024L * 2816;
constexpr size_t OFF_WT = 0;
constexpr size_t OFF_G = OFF_WT + (size_t)W_LAYER * 2;
constexpr size_t OFF_BETA = OFF_G + (size_t)TT * 4 * 4;
constexpr size_t OFF_CNT = OFF_BETA + (size_t)TT * 4 * 4;
constexpr size_t OFF_GL = OFF_CNT + 4096;
constexpr size_t OFF_H = OFF_GL + 8192;
constexpr size_t OFF_R = OFF_H + (size_t)TT * DM * 2;
constexpr size_t OFF_M = OFF_R + (size_t)TT * PC * 2;
constexpr size_t OFF_SIGC = OFF_M + (size_t)TT * DM * 2;
constexpr size_t WS_NEED = OFF_SIGC + (size_t)TT * DM * 2;
static_assert(WS_NEED <= ((size_t)512 << 20), "workspace budget");
constexpr size_t OFF_ACT = OFF_R;
constexpr size_t OFF_OUTF = OFF_R;
constexpr size_t OFF_OUTF2 = OFF_R + (size_t)TT * DFF * 2;
static_assert(OFF_OUTF2 + (size_t)TT * DM * 4 <= WS_NEED, "ws layout");

constexpr int SMEM_BYTES = 73728;
constexpr int LDT = 72;
constexpr int LDC = 132;

struct Params {
  const float* x; const float* ln_mix_pre; const float* w_in; const float* sw_sinks; const float* gdn_conv;
  const float* gdn_a_log; const float* gdn_dt_bias; const float* gdn_norm; const float* w_br[3]; const float* w_out;
  const float* ln_mix_post; const float* ln_ffn_pre; const float* w_up; const float* ffn_conv; const float* w_down;
  const float* ln_ffn_post; float* out; unsigned char* ws;
};

__shared__ __attribute__((aligned(16))) unsigned char smem_raw[SMEM_BYTES];

__device__ __forceinline__ int tid_op() { int t = threadIdx.x; asm volatile("" : "+v"(t)); return t; }
__device__ __forceinline__ int bid_op() { int b = blockIdx.x; asm volatile("" : "+s"(b)); return b; }
__device__ __forceinline__ float bf2f(u16 h) { return __uint_as_float(((unsigned)h) << 16); }
__device__ __forceinline__ u16 f2bf(float f) { return __builtin_bit_cast(u16, (__bf16)f); }
typedef __bf16 bf16v2 __attribute__((ext_vector_type(2)));
__device__ __forceinline__ unsigned pack2(float a, float b) {
  const bf16v2 v = {(__bf16)a, (__bf16)b};
  return __builtin_bit_cast(unsigned, v);
}
__device__ __forceinline__ float lo16(unsigned w) { return __uint_as_float(w << 16); }
__device__ __forceinline__ float hi16(unsigned w) { return __uint_as_float(w & 0xffff0000u); }
__device__ __forceinline__ float wave_sum(float v) {
#pragma unroll
  for (int m = 32; m >= 1; m >>= 1) v += __shfl_xor(v, m);
  return v;
}
__device__ __forceinline__ void lds_barrier() { asm volatile("s_waitcnt lgkmcnt(0)\n\ts_barrier" ::: "memory"); }
__device__ __forceinline__ float sigmoidf_(float x) { return 1.f / (1.f + __expf(-x)); }
__device__ __forceinline__ float softplusf_(float x) { return fmaxf(x, 0.f) + __logf(1.f + __expf(-fabsf(x))); }

__device__ __forceinline__ void transpose_job(const Params& p, int job) {
  const int layer = job / 4608;
  int r = job % 4608;
  const float* src; long ld; int K; long dsto; int col0; int nt, kt;
  u16* wt = (u16*)(p.ws + OFF_WT);
  if (r < 1088) { K = 1024; nt = r / 16; kt = r % 16; src = p.w_in + (long)layer * DM * INC; ld = INC; col0 = nt * 64; dsto = W_IN; }
  else if (r < 1856) { r -= 1088; K = 1024; nt = r / 16; kt = r % 16; src = p.w_in + (long)layer * DM * INC; ld = INC; col0 = 4360 + nt * 64; dsto = W_GATE; }
  else if (r < 2240) { r -= 1856; const int br = r / 128; r %= 128; K = 512; nt = r / 8; kt = r % 8; src = (br == 0 ? p.w_br[0] : (br == 1 ? p.w_br[1] : p.w_br[2])) + (long)layer * 512 * 1024; ld = 1024; col0 = nt * 64; dsto = W_BR + (long)br * 1024 * 512; }
  else if (r < 2496) { r -= 2240; K = 1024; nt = r / 16; kt = r % 16; src = p.w_out + (long)layer * 1024 * 1024; ld = 1024; col0 = nt * 64; dsto = W_OUT; }
  else if (r < 3904) { r -= 2496; K = 1024; nt = r / 16; kt = r % 16; src = p.w_up + (long)layer * 1024 * 5632; ld = 5632; col0 = (nt & 1) * DFF + (nt >> 1) * 64; dsto = W_UP; }
  else { r -= 3904; K = 2816; nt = r / 44; kt = r % 44; src = p.w_down + (long)layer * 2816 * 1024; ld = 1024; col0 = nt * 64; dsto = W_DOWN; }
  float* tile = (float*)smem_raw;
  const int tid = tid_op();
  __syncthreads();
  {
    const int tx = tid & 63, ty = tid >> 6;
    const float* s = src + (long)(kt * 64) * ld + col0 + tx;
#pragma unroll 4
    for (int kk = ty; kk < 64; kk += 4) tile[kk * 65 + tx] = s[(long)kk * ld];
  }
  __syncthreads();
  {
    const int c2 = tid & 31, r0 = tid >> 5;
    unsigned* d = (unsigned*)(wt + dsto + (long)(nt * 64) * K + kt * 64);
#pragma unroll
    for (int i = 0; i < 8; ++i) {
      const int rr = r0 + 8 * i;
      d[((long)rr * K) / 2 + c2] = pack2(tile[(2 * c2) * 65 + rr], tile[(2 * c2 + 1) * 65 + rr]);
    }
  }
}

__device__ __forceinline__ void rownorm_phase(const Params& p, int mode, const u16* upd, const float* gpost, const float* gpre, int abl) {
  const int tid = tid_op(), lane = tid & 63, wid = tid >> 6;
  float* sW = (float*)smem_raw;
  __syncthreads();
  if (abl >= 0) {
    const float* w = p.w_in + (long)abl * DM * INC + 4352;
    for (int k = tid; k < 1024; k += 256) {
      const float4 a = *(const float4*)(w + (long)k * INC);
      const float4 b = *(const float4*)(w + (long)k * INC + 4);
      sW[0 * 1024 + k] = a.x; sW[1 * 1024 + k] = a.y; sW[2 * 1024 + k] = a.z; sW[3 * 1024 + k] = a.w;
      sW[4 * 1024 + k] = b.x; sW[5 * 1024 + k] = b.y; sW[6 * 1024 + k] = b.z; sW[7 * 1024 + k] = b.w;
    }
  }
  __syncthreads();
  u16* H = (u16*)(p.ws + OFF_H);
  float* G = (float*)(p.ws + OFF_G);
  float* BT = (float*)(p.ws + OFF_BETA);
  for (int row = bid_op() * 4 + wid; row < TT; row += gridDim.x * 4) {
    float4 xv[4];
    if (mode == 0) {
#pragma unroll
      for (int i = 0; i < 4; ++i) xv[i] = *(const float4*)(p.x + (long)row * DM + lane * 4 + 256 * i);
    } else {
      float4 u[4];
      float ss = 0.f;
#pragma unroll
      for (int i = 0; i < 4; ++i) {
        const uint2 ub_ = *(const uint2*)(upd + (long)row * DM + lane * 4 + 256 * i);
        u[i] = make_float4(lo16(ub_.x), hi16(ub_.x), lo16(ub_.y), hi16(ub_.y));
        ss += u[i].x * u[i].x + u[i].y * u[i].y + u[i].z * u[i].z + u[i].w * u[i].w;
      }
      ss = wave_sum(ss);
      const float rs = rsqrtf(ss * (1.f / 1024.f) + 1e-6f);
#pragma unroll
      for (int i = 0; i < 4; ++i) {
        const float4 o = *(const float4*)(p.out + (long)row * DM + lane * 4 + 256 * i);
        const float4 g = *(const float4*)(gpost + lane * 4 + 256 * i);
        xv[i].x = o.x + u[i].x * rs * g.x; xv[i].y = o.y + u[i].y * rs * g.y;
        xv[i].z = o.z + u[i].z * rs * g.z; xv[i].w = o.w + u[i].w * rs * g.w;
      }
    }
#pragma unroll
    for (int i = 0; i < 4; ++i) *(float4*)(p.out + (long)row * DM + lane * 4 + 256 * i) = xv[i];
    if (gpre) {
      float ss = 0.f;
#pragma unroll
      for (int i = 0; i < 4; ++i) ss += xv[i].x * xv[i].x + xv[i].y * xv[i].y + xv[i].z * xv[i].z + xv[i].w * xv[i].w;
      ss = wave_sum(ss);
      const float rs = rsqrtf(ss * (1.f / 1024.f) + 1e-6f);
      float4 hv[4];
#pragma unroll
      for (int i = 0; i < 4; ++i) {
        const float4 g = *(const float4*)(gpre + lane * 4 + 256 * i);
        hv[i].x = xv[i].x * rs * g.x; hv[i].y = xv[i].y * rs * g.y; hv[i].z = xv[i].z * rs * g.z; hv[i].w = xv[i].w * rs * g.w;
        uint2 pk; pk.x = pack2(hv[i].x, hv[i].y); pk.y = pack2(hv[i].z, hv[i].w);
        *(uint2*)(H + (long)row * DM + lane * 4 + 256 * i) = pk;
      }
      if (abl >= 0) {
        float pj[8];
#pragma unroll
        for (int j = 0; j < 8; ++j) {
          float a = 0.f;
#pragma unroll
          for (int i = 0; i < 4; ++i) {
            const float4 w = *(const float4*)(sW + j * 1024 + lane * 4 + 256 * i);
            a += hv[i].x * w.x + hv[i].y * w.y + hv[i].z * w.z + hv[i].w * w.w;
          }
          pj[j] = wave_sum(a);
        }
        if (lane == 0) {
#pragma unroll
          for (int j = 0; j < 4; ++j) {
            const float A = __expf(p.gdn_a_log[abl * 4 + j]);
            G[(long)row * 4 + j] = -A * softplusf_(pj[j] + p.gdn_dt_bias[abl * 4 + j]);
            BT[(long)row * 4 + j] = sigmoidf_(pj[4 + j]);
          }
        }
      }
    }
  }
}

template <int NJ>
struct GemmPf {
  v4u ra0[4], rb0[2 * NJ], ra1[4], rb1[2 * NJ], ra2[4], rb2[2 * NJ], ra3[4], rb3[2 * NJ];
  const u16* apr[4];
  const u16* bp;
  long ldb;
  int nk;
  bool av[4];
};
template <int NJ>
__device__ __forceinline__ void gemm_prefetch(GemmPf<NJ>& s, const u16* __restrict__ A, long lda, int grow0, int row_lo,
                                              int row_hi, const u16* __restrict__ Bt, long ldb, int K) {
  const int tid = tid_op();
  const int srow = tid >> 3, sc = (tid & 7) * 8;
  s.bp = Bt + (long)srow * ldb + sc;
  s.ldb = ldb;
  s.nk = K / 64;
#pragma unroll
  for (int i = 0; i < 4; ++i) {
    const int gr = grow0 + srow + 32 * i;
    s.av[i] = (gr >= row_lo) && (gr < row_hi);
    s.apr[i] = A + (long)min(max(gr, row_lo), row_hi - 1) * lda + sc;
  }
#pragma unroll
  for (int i = 0; i < 4; ++i) s.ra0[i] = *(const v4u*)(s.apr[i]);
#pragma unroll
  for (int i = 0; i < 2 * NJ; ++i) s.rb0[i] = *(const v4u*)(s.bp + (long)(32 * i) * ldb);
}
template <int NJ, bool MASK>
__device__ __forceinline__ void gemm_main(GemmPf<NJ>& s, f32x16 (&acc)[2][NJ]) {
  const int tid = tid_op(), lane = tid & 63, wid = tid >> 6, wm = wid >> 1, wn = wid & 1;
  u16* sA = (u16*)smem_raw;
  u16* sB = sA + 2 * 128 * LDT;
  const int srow = tid >> 3, sc = (tid & 7) * 8;
  v4u (&ra0)[4] = s.ra0; v4u (&rb0)[2 * NJ] = s.rb0; v4u (&ra1)[4] = s.ra1; v4u (&rb1)[2 * NJ] = s.rb1;
  v4u (&ra2)[4] = s.ra2; v4u (&rb2)[2 * NJ] = s.rb2; v4u (&ra3)[4] = s.ra3; v4u (&rb3)[2 * NJ] = s.rb3;
  const u16* (&apr)[4] = s.apr;
  bool (&av)[4] = s.av;
  const u16* bp = s.bp;
  const long ldb = s.ldb;
  const int nk = s.nk;
  const v4u zero4 = {0u, 0u, 0u, 0u};
#define G_LOAD(RA, RB, KT)                                                                              \
  {                                                                                                     \
    const int k0_ = (KT) * 64;                                                                          \
    _Pragma("unroll") for (int i = 0; i < 4; ++i) RA[i] = *(const v4u*)(apr[i] + k0_);                   \
    _Pragma("unroll") for (int i = 0; i < 2 * NJ; ++i) RB[i] = *(const v4u*)(bp + (long)(32 * i) * ldb + k0_);           \
  }
#define G_STORE(RA, RB, BUF)                                                                            \
  {                                                                                                     \
    u16* dA_ = sA + (BUF) * 128 * LDT;                                                                  \
    u16* dB_ = sB + (BUF) * 128 * LDT;                                                                  \
    _Pragma("unroll") for (int i = 0; i < 4; ++i) *(v4u*)(dA_ + (srow + 32 * i) * LDT + sc) = av[i] ? RA[i] : zero4; \
    _Pragma("unroll") for (int i = 0; i < 2 * NJ; ++i) *(v4u*)(dB_ + (srow + 32 * i) * LDT + sc) = RB[i]; \
  }
#define G_FRAGS(ST, KS)                                                                                 \
  {                                                                                                     \
    _Pragma("unroll") for (int i = 0; i < 2; ++i) af[ST][i] = *(const bf16x8*)(cA + i * 32 * LDT + (KS) * 16); \
    _Pragma("unroll") for (int j = 0; j < NJ; ++j) bfr[ST][j] = *(const bf16x8*)(cB + j * 32 * LDT + (KS) * 16); \
  }
#define G_COMPUTE(BUF, RA, RB, DOST, LA, LB, LKT, NEXT)                                                 \
  {                                                                                                     \
    const u16* cA = sA + (BUF) * 128 * LDT + (wm * 64 + fr) * LDT + fh;                                 \
    const u16* cB = sB + (BUF) * 128 * LDT + (wn * 32 * NJ + fr) * LDT + fh;                            \
    const u16* nA = sA + ((BUF) ^ 1) * 128 * LDT + (wm * 64 + fr) * LDT + fh;                           \
    const u16* nB = sB + ((BUF) ^ 1) * 128 * LDT + (wn * 32 * NJ + fr) * LDT + fh;                      \
    u16* dA_ = sA + ((BUF) ^ 1) * 128 * LDT + srow * LDT + sc;                                          \
    u16* dB_ = sB + ((BUF) ^ 1) * 128 * LDT + srow * LDT + sc;                                          \
    const bool dost_ = (DOST);                                                                          \
    const bool next_ = (NEXT);                                                                          \
    const int lk0_ = (LKT) * 64;                                                                        \
    constexpr int NMF = 2 * NJ, NFR = 2 + NJ, NE = 4 + 2 * NJ;                                          \
    _Pragma("unroll") for (int ks = 0; ks < 4; ++ks) {                                                  \
                  \
      if (ks == 3) lds_barrier();                                                                       \
      _Pragma("unroll") for (int m = 0; m < NMF; ++m) {                                                 \
        const int t_ = ks * NMF + m;                                                                    \
        if (ks < 3) {                                                                                   \
          _Pragma("unroll") for (int f = 0; f < NFR; ++f)                                               \
            if ((f * NMF) / NFR == m) {                                                                 \
              if (f < 2) af[(ks + 1) & 1][f] = *(const bf16x8*)(cA + f * 32 * LDT + (ks + 1) * 16);     \
              else bfr[(ks + 1) & 1][f - 2] = *(const bf16x8*)(cB + (f - 2) * 32 * LDT + (ks + 1) * 16); \
            }                                                                                           \
        } else if (next_) {                                                                             \
          _Pragma("unroll") for (int f = 0; f < NFR; ++f)                                               \
            if ((f * NMF) / NFR == m) {                                                                 \
              if (f < 2) af[0][f] = *(const bf16x8*)(nA + f * 32 * LDT);                                \
              else bfr[0][f - 2] = *(const bf16x8*)(nB + (f - 2) * 32 * LDT);                           \
            }                                                                                           \
        }                                                                                               \
        _Pragma("unroll") for (int e = 0; e < NE; ++e) {                                                \
          if ((e * 4 * NMF) / NE == t_) {                                                               \
            if (e < 4) LA[e] = *(const v4u*)(apr[e] + lk0_);                                            \
            else LB[e - 4] = *(const v4u*)(bp + (long)(32 * (e - 4)) * ldb + lk0_);                     \
          }                                                                                             \
          if (dost_ && (e * 3 * NMF) / NE == t_) {                                                      \
            if (e < 4) *(v4u*)(dA_ + 32 * e * LDT) = (!MASK || av[e]) ? RA[e] : zero4;                  \
            else *(v4u*)(dB_ + 32 * (e - 4) * LDT) = RB[e - 4];                                         \
          }                                                                                             \
        }                                                                                               \
        __builtin_amdgcn_sched_barrier(0);                                                              \
        acc[m / NJ][m % NJ] = __builtin_amdgcn_mfma_f32_32x32x16_bf16(af[ks & 1][m / NJ], bfr[ks & 1][m % NJ], \
                                                                       acc[m / NJ][m % NJ], 0, 0, 0);   \
        __builtin_amdgcn_sched_barrier(0);                                                              \
      }                                                                                                 \
    }                                                                                                   \
  }
  G_LOAD(ra1, rb1, 1);
  G_LOAD(ra2, rb2, 2);
  __syncthreads();
  G_STORE(ra0, rb0, 0);
  __syncthreads();
  const int fr = lane & 31, fh = (lane >> 5) * 8;
  bf16x8 af[2][2], bfr[2][NJ];
#pragma unroll
  for (int i = 0; i < 2; ++i) af[0][i] = *(const bf16x8*)(sA + (wm * 64 + fr + i * 32) * LDT + fh);
#pragma unroll
  for (int j = 0; j < NJ; ++j) bfr[0][j] = *(const bf16x8*)(sB + (wn * 32 * NJ + fr + j * 32) * LDT + fh);
  for (int kt = 0; kt < nk; kt += 4) {
    G_COMPUTE(0, ra1, rb1, true, ra3, rb3, min(kt + 3, nk - 1), true);
    G_COMPUTE(1, ra2, rb2, true, ra0, rb0, min(kt + 4, nk - 1), true);
    G_COMPUTE(0, ra3, rb3, true, ra1, rb1, min(kt + 5, nk - 1), true);
    G_COMPUTE(1, ra0, rb0, kt + 4 < nk, ra2, rb2, min(kt + 6, nk - 1), kt + 4 < nk);
  }
#undef G_LOAD
#undef G_STORE
#undef G_COMPUTE
#undef G_FRAGS
}

template <int NJ, bool MASK = false>
__device__ __forceinline__ void gemm_core(const u16* __restrict__ A, long lda, int grow0, int row_lo, int row_hi,
                                          const u16* __restrict__ Bt, long ldb, int K, f32x16 (&acc)[2][NJ]) {
  GemmPf<NJ> s;
  gemm_prefetch<NJ>(s, A, lda, grow0, row_lo, row_hi, Bt, ldb, K);
  gemm_main<NJ, MASK>(s, acc);
}


template <int NJ>
__device__ __forceinline__ void acc_zero(f32x16 (&acc)[2][NJ]) {
#pragma unroll
  for (int i = 0; i < 2; ++i)
#pragma unroll
    for (int j = 0; j < NJ; ++j)
#pragma unroll
      for (int r = 0; r < 16; ++r) acc[i][j][r] = 0.f;
}

template <int NJ>
__device__ __forceinline__ void acc_to_lds(const f32x16 (&acc)[2][NJ]) {
  const int tid = tid_op(), lane = tid & 63, wid = tid >> 6, wm = wid >> 1, wn = wid & 1;
  float* sC = (float*)smem_raw;
#pragma unroll
  for (int i = 0; i < 2; ++i)
#pragma unroll
    for (int j = 0; j < NJ; ++j)
#pragma unroll
      for (int r = 0; r < 16; ++r) {
        const int row = wm * 64 + i * 32 + (r & 3) + 8 * (r >> 2) + 4 * (lane >> 5);
        const int col = wn * 32 * NJ + j * 32 + (lane & 31);
        sC[row * LDC + col] = acc[i][j][r];
      }
  __syncthreads();
}

template <int NCOL>
__device__ __forceinline__ void store_bf16_tile(u16* C, long ldc) {
  const float* sC = (const float*)smem_raw;
  const int tid = tid_op();
  constexpr int TPR = NCOL / 8;
  constexpr int RPI = 256 / TPR;
  const int r0 = tid / TPR, c = (tid % TPR) * 8;
#pragma unroll
  for (int i = 0; i < 128 / RPI; ++i) {
    const int r = r0 + RPI * i;
    const float4 a = *(const float4*)(sC + r * LDC + c);
    const float4 b = *(const float4*)(sC + r * LDC + c + 4);
    uint4 o; o.x = pack2(a.x, a.y); o.y = pack2(a.z, a.w); o.z = pack2(b.x, b.y); o.w = pack2(b.z, b.w);
    *(uint4*)(C + (long)r * ldc + c) = o;
  }
}
__device__ __forceinline__ void store_f32_tile(float* C, long ldc) {
  const float* sC = (const float*)smem_raw;
  const int tid = tid_op();
  const int r0 = tid >> 5, c = (tid & 31) * 4;
#pragma unroll 4
  for (int i = 0; i < 16; ++i) {
    const int r = r0 + 8 * i;
    *(float4*)(C + (long)r * ldc + c) = *(const float4*)(sC + r * LDC + c);
  }
}

__device__ __forceinline__ int xcd_linear(int k) {
  const int G = gridDim.x, bid = bid_op();
  return k * G + (bid & 7) * (G >> 3) + (bid >> 3);
}
__device__ __forceinline__ void tile_mn(int L, int Mt, int Nt, int& m, int& n) {
  const int band = L / (8 * Nt), rem = L - band * 8 * Nt;
  const int R = min(8, Mt - 8 * band);
  n = rem / R;
  m = 8 * band + (rem - n * R);
}

struct TileIP { int kind, grow0, row_lo, row_hi, ncol, nt; };
__device__ __forceinline__ TileIP inproj_decode(int id) {
  TileIP t;
  if (id < 256 * 22) {
    int m, nn;
    tile_mn(id, 256, 22, m, nn);
    t.kind = 0; t.grow0 = m * 128; t.row_lo = 0; t.row_hi = TT; t.nt = 0;
    t.ncol = nn < 18 ? nn * 128 : 3840 + (nn - 18) * 128;
  } else {
    int mt, nt;
    tile_mn(id - 256 * 22, 264, 12, mt, nt);
    const int b = mt / 132, tt = mt % 132;
    t.kind = 1; t.grow0 = b * SEQ + 125 * tt - 3; t.row_lo = b * SEQ; t.row_hi = (b + 1) * SEQ; t.nt = nt;
    t.ncol = C_CQ + nt * 128;
  }
  return t;
}
__device__ __forceinline__ void phase_inproj(const Params& p, int layer) {
  const u16* H = (const u16*)(p.ws + OFF_H);
  const u16* W = (const u16*)(p.ws + OFF_WT) + W_IN;
  u16* P = (u16*)(p.ws + OFF_R);
  constexpr int N_ALL = 256 * 22 + 264 * 12;
  GemmPf<2> pf;
  int kk = 0;
  int id = xcd_linear(0);
  bool have = id < N_ALL;
  TileIP t = inproj_decode(have ? id : 0);
  if (have) gemm_prefetch<2>(pf, H, DM, t.grow0, t.row_lo, t.row_hi, W + (long)t.ncol * DM, DM, DM);
  while (have) {
    f32x16 acc[2][2];
    acc_zero<2>(acc);
    const TileIP c = t;
    if (c.grow0 >= c.row_lo && c.grow0 + 128 <= c.row_hi) gemm_main<2, false>(pf, acc);
    else gemm_main<2, true>(pf, acc);
    ++kk;
    id = xcd_linear(kk);
    have = id < N_ALL;
    t = inproj_decode(have ? id : 0);
    if (have) gemm_prefetch<2>(pf, H, DM, t.grow0, t.row_lo, t.row_hi, W + (long)t.ncol * DM, DM, DM);
    acc_to_lds<2>(acc);
    if (c.kind == 0) {
      store_bf16_tile<128>(P + (long)c.grow0 * PC + c.ncol, PC);
    } else {
      const int tid = tid_op(), lane = tid & 63, wid = tid >> 6;
      const float* sC = (const float*)smem_raw;
      const float* cw = p.gdn_conv + (long)layer * 4 * 1536 + c.nt * 128 + 2 * lane;
      const float2 w0 = *(const float2*)(cw), w1 = *(const float2*)(cw + 1536), w2 = *(const float2*)(cw + 2 * 1536),
                   w3 = *(const float2*)(cw + 3 * 1536);
      const int rs = 3 + 32 * wid, re = min(rs + 32, 128);
      float2 x0 = *(const float2*)(sC + (rs - 3) * LDC + 2 * lane);
      float2 x1 = *(const float2*)(sC + (rs - 2) * LDC + 2 * lane);
      float2 x2 = *(const float2*)(sC + (rs - 1) * LDC + 2 * lane);
      for (int r = rs; r < re; ++r) {
        const float2 x3 = *(const float2*)(sC + r * LDC + 2 * lane);
        float ya = w0.x * x0.x + w1.x * x1.x + w2.x * x2.x + w3.x * x3.x;
        float yb = w0.y * x0.y + w1.y * x1.y + w2.y * x2.y + w3.y * x3.y;
        ya = ya * sigmoidf_(ya);
        yb = yb * sigmoidf_(yb);
        if (c.nt < 8) {
          const float ss = wave_sum(ya * ya + yb * yb);
          const float sc = rsqrtf(ss + 1e-6f);
          ya *= sc; yb *= sc;
        }
        const int gr = c.grow0 + r;
        if (gr < c.row_hi) *(unsigned*)(P + (long)gr * PC + c.ncol + 2 * lane) = pack2(ya, yb);
        x0 = x1; x1 = x2; x2 = x3;
      }
    }
  }
}

__device__ __forceinline__ void merge_tile(const Params& p, int m, int nq, int mode) {
  const u16* H = (const u16*)(p.ws + OFF_H);
  const u16* WL = (const u16*)(p.ws + OFF_WT);
  u16* P = (u16*)(p.ws + OFF_R);
  u16* SIGC = (u16*)(p.ws + OFF_SIGC);
  const int n0 = nq * 64;
  const int tid = tid_op();
  const int r0 = tid >> 3, c = (tid & 7) * 8;
  u16* part = P + (long)(m * 128) * PC + C_AK + n0;
  u16* sigp = SIGC + (long)(m * 128) * DM + n0;
  if (mode == 1) {
    f32x16 mg[2][1];
    acc_zero<1>(mg);
#pragma unroll 1
    for (int br = 0; br < 2; ++br) {
      f32x16 ga[2][1];
      acc_zero<1>(ga);
      gemm_core<1>(H, DM, m * 128, 0, TT, WL + W_GATE + (long)(br * 1024 + n0) * DM, DM, DM, ga);
#pragma unroll
      for (int i = 0; i < 2; ++i)
#pragma unroll
        for (int r = 0; r < 16; ++r) ga[i][0][r] = sigmoidf_(ga[i][0][r]);
      f32x16 ba[2][1];
      acc_zero<1>(ba);
      const int ycol = br == 0 ? C_AQ : C_BQ;
      gemm_core<1>(P + ycol, PC, m * 128, 0, TT, WL + W_BR + (long)br * 1024 * 512 + (long)n0 * 512, 512, 512, ba);
#pragma unroll
      for (int i = 0; i < 2; ++i)
#pragma unroll
        for (int r = 0; r < 16; ++r) mg[i][0][r] += ga[i][0][r] * ba[i][0][r];
    }
    acc_to_lds<1>(mg);
    store_bf16_tile<64>(part, PC);
    f32x16 gc[2][1];
    acc_zero<1>(gc);
    gemm_core<1>(H, DM, m * 128, 0, TT, WL + W_GATE + (long)(2 * 1024 + n0) * DM, DM, DM, gc);
#pragma unroll
    for (int i = 0; i < 2; ++i)
#pragma unroll
      for (int r = 0; r < 16; ++r) gc[i][0][r] = sigmoidf_(gc[i][0][r]);
    acc_to_lds<1>(gc);
    store_bf16_tile<64>(sigp, DM);
  } else {
    f32x16 ba[2][1];
    acc_zero<1>(ba);
    gemm_core<1>(P + C_CZ, PC, m * 128, 0, TT, WL + W_BR + 2L * 1024 * 512 + (long)n0 * 512, 512, 512, ba);
    acc_to_lds<1>(ba);
    const float* sC = (const float*)smem_raw;
    u16* outp = (u16*)(p.ws + OFF_M) + (long)(m * 128) * DM + n0;
#pragma unroll
    for (int i = 0; i < 4; ++i) {
      const int r = r0 + 32 * i;
      float4 x = *(const float4*)(sC + r * LDC + c);
      float4 y = *(const float4*)(sC + r * LDC + c + 4);
      const uint4 v = *(const uint4*)(part + (long)r * PC + c);
      const uint4 g = *(const uint4*)(sigp + (long)r * DM + c);
      x.x = lo16(v.x) + lo16(g.x) * x.x; x.y = hi16(v.x) + hi16(g.x) * x.y;
      x.z = lo16(v.y) + lo16(g.y) * x.z; x.w = hi16(v.y) + hi16(g.y) * x.w;
      y.x = lo16(v.z) + lo16(g.z) * y.x; y.y = hi16(v.z) + hi16(g.z) * y.y;
      y.z = lo16(v.w) + lo16(g.w) * y.z; y.w = hi16(v.w) + hi16(g.w) * y.w;
      uint4 o; o.x = pack2(x.x, x.y); o.y = pack2(x.z, x.w); o.z = pack2(y.x, y.y); o.w = pack2(y.z, y.w);
      *(uint4*)(outp + (long)r * DM + c) = o;
    }
  }
}

__device__ __forceinline__ void phase_merge(const Params& p, int layer) {
  (void)layer;
  for (int kk = 0;; ++kk) {
    const int id = xcd_linear(kk);
    if (kk * (int)gridDim.x >= 256 * 16) break;
    if (id >= 256 * 16) continue;
    int m, nq;
    tile_mn(id, 256, 16, m, nq);
    merge_tile(p, m, nq, 2);
  }
}

__device__ __forceinline__ void phase_gemm_f32(const u16* A, long lda, const u16* Wt, int K, u16* C) {
  GemmPf<2> pf;
  int kk = 0, m = 0, nq = 0;
  int id = xcd_linear(0);
  bool have = id < 256 * 8;
  if (have) {
    tile_mn(id, 256, 8, m, nq);
    gemm_prefetch<2>(pf, A, lda, m * 128, 0, TT, Wt + (long)(nq * 128) * K, K, K);
  }
  while (have) {
    f32x16 acc[2][2];
    acc_zero<2>(acc);
    gemm_main<2, false>(pf, acc);
    const int cm = m, cn = nq;
    ++kk;
    id = xcd_linear(kk);
    have = id < 256 * 8;
    if (have) {
      tile_mn(id, 256, 8, m, nq);
      gemm_prefetch<2>(pf, A, lda, m * 128, 0, TT, Wt + (long)(nq * 128) * K, K, K);
    }
    acc_to_lds<2>(acc);
    store_bf16_tile<128>(C + (long)(cm * 128) * DM + cn * 128, DM);
  }
}

__device__ __forceinline__ void phase_up(const Params& p, int layer) {
  const u16* H = (const u16*)(p.ws + OFF_H);
  const u16* W = (const u16*)(p.ws + OFF_WT) + W_UP;
  u16* ACT = (u16*)(p.ws + OFF_ACT);
  GemmPf<2> pf;
  int kk = 0, mt = 0, nb = 0;
  int id = xcd_linear(0);
  bool have = id < 262 * 44;
  if (have) {
    tile_mn(id, 262, 44, mt, nb);
    const int b = mt / 131, tt = mt % 131;
    gemm_prefetch<2>(pf, H, DM, b * SEQ + 126 * tt - 2, b * SEQ, (b + 1) * SEQ, W + (long)(nb * 128) * DM, DM, DM);
  }
  while (have) {
    f32x16 acc[2][2];
    acc_zero<2>(acc);
    const int cb = mt / 131, ctt = mt % 131, cnb = nb;
    const int grow0 = cb * SEQ + 126 * ctt - 2, row_lo = cb * SEQ, row_hi = (cb + 1) * SEQ;
    if (grow0 >= row_lo && grow0 + 128 <= row_hi) gemm_main<2, false>(pf, acc);
    else gemm_main<2, true>(pf, acc);
    ++kk;
    id = xcd_linear(kk);
    have = id < 262 * 44;
    if (have) {
      tile_mn(id, 262, 44, mt, nb);
      const int b = mt / 131, tt = mt % 131;
      gemm_prefetch<2>(pf, H, DM, b * SEQ + 126 * tt - 2, b * SEQ, (b + 1) * SEQ, W + (long)(nb * 128) * DM, DM, DM);
    }
    acc_to_lds<2>(acc);
    const int tid = tid_op();
    const float* sC = (const float*)smem_raw;
    const int c = tid & 63, rg = tid >> 6;
    const float* fc = p.ffn_conv + (long)layer * 3 * 5632 + cnb * 64 + c;
    const float g0 = fc[0], g1 = fc[5632], g2 = fc[2 * 5632];
    const float u0 = fc[DFF], u1 = fc[5632 + DFF], u2 = fc[2 * 5632 + DFF];
    const int rs = 2 + 32 * rg, re = min(rs + 32, 128);
    float ga = sC[(rs - 2) * LDC + c], gb = sC[(rs - 1) * LDC + c];
    float ua = sC[(rs - 2) * LDC + 64 + c], ub = sC[(rs - 1) * LDC + 64 + c];
    for (int r = rs; r < re; ++r) {
      const float gc = sC[r * LDC + c], uc = sC[r * LDC + 64 + c];
      const float fg = g0 * ga + g1 * gb + g2 * gc;
      const float fu = u0 * ua + u1 * ub + u2 * uc;
      const float t = 0.7978845608028654f * (fg + 0.044715f * fg * fg * fg);
      const float ge = fg / (1.f + __expf(-2.f * t));
      const int gr = grow0 + r;
      if (gr < row_hi) ACT[(long)gr * DFF + cnb * 64 + c] = f2bf(ge * fu);
      ga = gb; gb = gc; ua = ub; ub = uc;
    }
  }
}

__device__ __forceinline__ bf16x8 pack8(const f32x16& v, int s) {
  typedef unsigned u32x4_ __attribute__((ext_vector_type(4)));
  u32x4_ r;
#pragma unroll
  for (int j = 0; j < 4; ++j) r[j] = pack2(v[8 * s + 2 * j], v[8 * s + 2 * j + 1]);
  return __builtin_bit_cast(bf16x8, r);
}
constexpr int ATT_LK = 72, ATT_LV = 136;
#define ATT_LOAD(KT, COLK, COLV)                                                            \
  {                                                                                         \
    const u16* kp_ = P + (rb + (long)(KT) * 128 + key_l) * PC + 32 * dq;                    \
    _Pragma("unroll") for (int i = 0; i < 4; ++i) {                                         \
      pk[i] = *(const v4u*)(kp_ + (COLK) + 8 * i);                                          \
      pv[i] = *(const v4u*)(kp_ + (COLV) + 8 * i);                                          \
    }                                                                                       \
  }
#define ATT_STORE()                                                                         \
  {                                                                                         \
    _Pragma("unroll") for (int i = 0; i < 4; ++i) *(v4u*)(sK + key_l * ATT_LK + 32 * dq + 8 * i) = pk[i]; \
    const int kpos_ = (key_l & ~12) | (((key_l >> 2) & 1) << 3) | (((key_l >> 3) & 1) << 2); \
    _Pragma("unroll") for (int i = 0; i < 4; ++i) {                                         \
      _Pragma("unroll") for (int e = 0; e < 4; ++e) {                                       \
        const unsigned w_ = pv[i][e];                                                       \
        sVT[(32 * dq + 8 * i + 2 * e) * ATT_LV + kpos_] = (u16)(w_ & 0xffffu);              \
        sVT[(32 * dq + 8 * i + 2 * e + 1) * ATT_LV + kpos_] = (u16)(w_ >> 16);              \
      }                                                                                     \
    }                                                                                       \
  }

__device__ __forceinline__ void sb_item(u16* P, int b, int hh, int qb) {
  const int tid = tid_op(), lane = tid & 63, wid = tid >> 6, fr = lane & 31, h5 = lane >> 5;
  u16* sK = (u16*)smem_raw;
  u16* sVT = sK + 128 * ATT_LK;
  const long rb = (long)b * SEQ;
  const int tq = qb * 128 + 32 * wid + fr;
  const float THR2 = -150.1f;
  bf16x8 qf[4];
  {
    const u16* qp = P + (rb + tq) * PC + C_AQ + hh * 64 + 8 * h5;
#pragma unroll
    for (int ks = 0; ks < 4; ++ks) qf[ks] = *(const bf16x8*)(qp + 16 * ks);
  }
  f32x16 oacc[2];
#pragma unroll
  for (int dt = 0; dt < 2; ++dt)
#pragma unroll
    for (int r = 0; r < 16; ++r) oacc[dt][r] = 0.f;
  float lrem = 0.f;
  const float qs = 0.125f * 1.4426950408889634f;
  const int key_l = tid & 127, dq = tid >> 7;
  v4u pk[4], pv[4];
  ATT_LOAD(qb, C_AK + hh * 64, C_AV + hh * 64);
  for (int kt = qb; kt >= 0; --kt) {
    __syncthreads();
    ATT_STORE();
    if (kt > 0) ATT_LOAD(kt - 1, C_AK + hh * 64, C_AV + hh * 64);
    __syncthreads();
    const bool diag = (kt == qb);
    if (__any(lrem > THR2)) {
#pragma unroll 1
      for (int st = diag ? wid : 3; st >= 0; --st) {
        f32x16 s;
#pragma unroll
        for (int r = 0; r < 16; ++r) s[r] = 0.f;
#pragma unroll
        for (int ks = 0; ks < 4; ++ks) {
          const bf16x8 a = *(const bf16x8*)(sK + (32 * st + fr) * ATT_LK + 16 * ks + 8 * h5);
          s = __builtin_amdgcn_mfma_f32_32x32x16_bf16(a, qf[ks], s, 0, 0, 0);
        }
        const bool mask_tile = diag && (st == wid);
        const int kbase = kt * 128 + 32 * st + 4 * h5;
        float ls[16];
#pragma unroll
        for (int r = 0; r < 16; ++r) {
          const float z = s[r] * qs;
          const float e = __builtin_amdgcn_exp2f(-fabsf(z));
          const float sp = fmaxf(z, 0.f) + __builtin_amdgcn_logf(1.f + e);
          const bool valid = !mask_tile || (kbase + 8 * (r >> 2) + (r & 3) < tq);
          ls[r] = valid ? -sp : 0.f;
          s[r] = valid ? z - sp : -INFINITY;
        }
        float G[4], Pg[4];
#pragma unroll
        for (int g = 0; g < 4; ++g) {
          G[g] = (ls[4 * g] + ls[4 * g + 1]) + (ls[4 * g + 2] + ls[4 * g + 3]);
          Pg[g] = __shfl_xor(G[g], 32);
        }
        const float T3 = G[3] + Pg[3], T2 = G[2] + Pg[2], T1 = G[1] + Pg[1], T0 = G[0] + Pg[0];
        float ab[4];
        ab[3] = lrem;
        ab[2] = lrem + T3;
        ab[1] = ab[2] + T2;
        ab[0] = ab[1] + T1;
        const float lnew = ab[0] + T0;
#pragma unroll
        for (int g = 0; g < 4; ++g) {
          float run = ab[g] + (h5 == 0 ? Pg[g] : 0.f);
#pragma unroll
          for (int e = 3; e >= 0; --e) {
            const float la = s[4 * g + e];
            s[4 * g + e] = __builtin_amdgcn_exp2f(la + run);
            run += ls[4 * g + e];
          }
        }
        lrem = lnew;
        const bf16x8 vb0 = pack8(s, 0), vb1 = pack8(s, 1);
#pragma unroll
        for (int dt = 0; dt < 2; ++dt) {
          const bf16x8 a0 = *(const bf16x8*)(sVT + (32 * dt + fr) * ATT_LV + 32 * st + 8 * h5);
          const bf16x8 a1 = *(const bf16x8*)(sVT + (32 * dt + fr) * ATT_LV + 32 * st + 16 + 8 * h5);
          oacc[dt] = __builtin_amdgcn_mfma_f32_32x32x16_bf16(a0, vb0, oacc[dt], 0, 0, 0);
          oacc[dt] = __builtin_amdgcn_mfma_f32_32x32x16_bf16(a1, vb1, oacc[dt], 0, 0, 0);
        }
      }
    }
    if (!__syncthreads_or(lrem > THR2)) break;
  }
  {
    u16* op = P + (rb + tq) * PC + C_AQ + hh * 64 + 4 * h5;
#pragma unroll
    for (int dt = 0; dt < 2; ++dt)
#pragma unroll
      for (int g = 0; g < 4; ++g) {
        uint2 o; o.x = pack2(oacc[dt][4 * g], oacc[dt][4 * g + 1]); o.y = pack2(oacc[dt][4 * g + 2], oacc[dt][4 * g + 3]);
        *(uint2*)(op + 32 * dt + 8 * g) = o;
      }
  }
}

__device__ __forceinline__ void swa_item(const Params& p, int layer, u16* P, int b, int qb, int hq) {
  const int tid = tid_op(), lane = tid & 63, wid = tid >> 6, fr = lane & 31, h5 = lane >> 5;
  u16* sK = (u16*)smem_raw;
  u16* sVT = sK + 128 * ATT_LK;
  const long rb = (long)b * SEQ;
  const int tq = qb * 128 + 32 * wid + fr;
  const int kvh = hq >> 2;
  const float L2E = 1.4426950408889634f;
  const float qs = 0.125f * L2E;
  const float slope2 = exp2f(-(float)(hq + 1)) * L2E;
  bf16x8 qf[4];
  u16* qp = P + (rb + tq) * PC + C_BQ + hq * 64;
#pragma unroll
  for (int ks = 0; ks < 4; ++ks) qf[ks] = *(const bf16x8*)(qp + 8 * h5 + 16 * ks);
  f32x16 oacc[2];
#pragma unroll
  for (int dt = 0; dt < 2; ++dt)
#pragma unroll
    for (int r = 0; r < 16; ++r) oacc[dt][r] = 0.f;
  float m = p.sw_sinks[layer * 8 + hq] * L2E;
  float l = (h5 == 0) ? 1.f : 0.f;
  const int key_l = tid & 127, dq = tid >> 7;
  v4u pk[4], pv[4];
  ATT_LOAD(qb, C_BK + kvh * 64, C_BV + kvh * 64);
  for (int kt = qb; kt >= 0 && kt >= qb - 1; --kt) {
    __syncthreads();
    ATT_STORE();
    if (kt == qb && kt > 0) ATT_LOAD(kt - 1, C_BK + kvh * 64, C_BV + kvh * 64);
    __syncthreads();
    const bool diag = (kt == qb);
    const int st_hi = diag ? wid : 3, st_lo = diag ? 0 : wid;
#pragma unroll 1
    for (int st = st_hi; st >= st_lo; --st) {
      f32x16 s;
#pragma unroll
      for (int r = 0; r < 16; ++r) s[r] = 0.f;
#pragma unroll
      for (int ks = 0; ks < 4; ++ks) {
        const bf16x8 a = *(const bf16x8*)(sK + (32 * st + fr) * ATT_LK + 16 * ks + 8 * h5);
        s = __builtin_amdgcn_mfma_f32_32x32x16_bf16(a, qf[ks], s, 0, 0, 0);
      }
      const int kbase = kt * 128 + 32 * st + 4 * h5;
      float mx = m;
#pragma unroll
      for (int r = 0; r < 16; ++r) {
        const int dist = tq - (kbase + 8 * (r >> 2) + (r & 3));
        const bool valid = (dist >= 0) && (dist < 128);
        s[r] = valid ? s[r] * qs - slope2 * (float)dist : -INFINITY;
        mx = fmaxf(mx, s[r]);
      }
      mx = fmaxf(mx, __shfl_xor(mx, 32));
      const float corr = __builtin_amdgcn_exp2f(m - mx);
      m = mx;
      float ps = 0.f;
#pragma unroll
      for (int r = 0; r < 16; ++r) {
        s[r] = __builtin_amdgcn_exp2f(s[r] - mx);
        ps += s[r];
      }
      l = l * corr + ps;
#pragma unroll
      for (int dt = 0; dt < 2; ++dt)
#pragma unroll
        for (int r = 0; r < 16; ++r) oacc[dt][r] *= corr;
      const bf16x8 vb0 = pack8(s, 0), vb1 = pack8(s, 1);
#pragma unroll
      for (int dt = 0; dt < 2; ++dt) {
        const bf16x8 a0 = *(const bf16x8*)(sVT + (32 * dt + fr) * ATT_LV + 32 * st + 8 * h5);
        const bf16x8 a1 = *(const bf16x8*)(sVT + (32 * dt + fr) * ATT_LV + 32 * st + 16 + 8 * h5);
        oacc[dt] = __builtin_amdgcn_mfma_f32_32x32x16_bf16(a0, vb0, oacc[dt], 0, 0, 0);
        oacc[dt] = __builtin_amdgcn_mfma_f32_32x32x16_bf16(a1, vb1, oacc[dt], 0, 0, 0);
      }
    }
  }
  l += __shfl_xor(l, 32);
  const float inv = 1.f / l;
#pragma unroll
  for (int dt = 0; dt < 2; ++dt)
#pragma unroll
    for (int g = 0; g < 4; ++g) {
      uint2 o;
      o.x = pack2(oacc[dt][4 * g] * inv, oacc[dt][4 * g + 1] * inv);
      o.y = pack2(oacc[dt][4 * g + 2] * inv, oacc[dt][4 * g + 3] * inv);
      *(uint2*)(qp + 4 * h5 + 32 * dt + 8 * g) = o;
    }
}

__device__ __forceinline__ int permg(int g) { return (g & ~3) | ((g & 1) << 1) | ((g >> 1) & 1); }

__device__ __forceinline__ void gdn_prep_item(const Params& p, u16* P, int b, int h, int n) {
  const int tid = tid_op(), lane = tid & 63, wid = tid >> 6, fr = lane & 31, h5 = lane >> 5, fh = h5 * 8;
  u16* sK = (u16*)smem_raw;
  u16* sQ = sK + 64 * 136;
  u16* sVT = sQ + 64 * 136;
  u16* sKT = sVT + 128 * 72;
  float* sGc = (float*)(sKT + 128 * 72);
  float* sEg = sGc + 64;
  float* sEgl = sGc + 128;
  float* sBe = sGc + 192;
  const long row0 = (long)b * SEQ + n * 64;
  const int ci = (b * 4 + h) * 256 + n;
  u16* kdT = (u16*)(p.ws + OFF_M) + (long)ci * 12288;
  u16* aout = kdT + 8192;
  const float* G = (const float*)(p.ws + OFF_G);
  const float* BT = (const float*)(p.ws + OFF_BETA);
  const float scale = 0.08838834764831845f;
  __syncthreads();
  if (wid == 0) {
    float g = G[(row0 + lane) * 4 + h];
#pragma unroll
    for (int o = 1; o < 64; o <<= 1) { const float t = __shfl_up(g, o); if (lane >= o) g += t; }
    const float glast = __shfl(g, 63);
    sGc[lane] = g; sEg[lane] = __expf(g); sEgl[lane] = __expf(glast - g); sBe[lane] = BT[(row0 + lane) * 4 + h];
    if (lane == 63) ((float*)(p.ws + OFF_GL))[ci] = __expf(g);
  }
#pragma unroll
  for (int i = 0; i < 4; ++i) {
    const int ch = tid + 256 * i, r = ch >> 4, c = (ch & 15) * 8;
    const u16* src = P + (row0 + r) * PC + h * 128 + c;
    *(uint4*)(sQ + r * 136 + c) = *(const uint4*)(src + C_CQ);
    *(uint4*)(sK + r * 136 + c) = *(const uint4*)(src + C_CK);
  }
  __syncthreads();
  const int bi = wid >> 1, bj = wid & 1;
  f32x16 kk, qk;
#pragma unroll
  for (int r = 0; r < 16; ++r) { kk[r] = 0.f; qk[r] = 0.f; }
  if (!(bi == 0 && bj == 1)) {
#pragma unroll
    for (int ks = 0; ks < 8; ++ks) {
      const bf16x8 ak = *(const bf16x8*)(sK + (32 * bi + fr) * 136 + ks * 16 + fh);
      const bf16x8 aq = *(const bf16x8*)(sQ + (32 * bi + fr) * 136 + ks * 16 + fh);
      const bf16x8 bk = *(const bf16x8*)(sK + (32 * bj + fr) * 136 + ks * 16 + fh);
      kk = __builtin_amdgcn_mfma_f32_32x32x16_bf16(ak, bk, kk, 0, 0, 0);
      qk = __builtin_amdgcn_mfma_f32_32x32x16_bf16(aq, bk, qk, 0, 0, 0);
    }
  }
#pragma unroll
  for (int i = 0; i < 8; ++i) {
    const int gi = tid + 256 * i, r = gi >> 5, g = gi & 31;
    const uint2 v = *(const uint2*)(sQ + r * 136 + 4 * g);
    const float f = scale * sEg[r];
    uint2 o; o.x = pack2(lo16(v.x) * f, hi16(v.x) * f); o.y = pack2(lo16(v.y) * f, hi16(v.y) * f);
    *(uint2*)(P + (row0 + r) * PC + C_CQ + h * 128 + 4 * permg(g)) = o;
  }
#pragma unroll
  for (int i = 0; i < 8; ++i) {
    const int gi = tid + 256 * i, dk = gi & 127, tg = gi >> 7;
    float kd[4], kb[4];
#pragma unroll
    for (int e = 0; e < 4; ++e) {
      const float kv = bf2f(sK[(4 * tg + e) * 136 + dk]);
      kd[e] = kv * sEgl[4 * tg + e];
      kb[e] = kv * sBe[4 * tg + e] * sEg[4 * tg + e];
    }
    uint2 o; o.x = pack2(kd[0], kd[1]); o.y = pack2(kd[2], kd[3]);
    *(uint2*)(kdT + dk * 64 + 4 * permg(tg)) = o;
    uint2 o2; o2.x = pack2(kb[0], kb[1]); o2.y = pack2(kb[2], kb[3]);
    *(uint2*)(sKT + dk * 72 + 4 * tg) = o2;
  }
#pragma unroll
  for (int i = 0; i < 4; ++i) {
    const int ch = tid + 256 * i, r = ch >> 4, c = (ch & 15) * 8;
    const uint4 v = *(const uint4*)(P + (row0 + r) * PC + C_CV + h * 128 + c);
    const float be = sBe[r];
    sVT[(c + 0) * 72 + r] = f2bf(lo16(v.x) * be); sVT[(c + 1) * 72 + r] = f2bf(hi16(v.x) * be);
    sVT[(c + 2) * 72 + r] = f2bf(lo16(v.y) * be); sVT[(c + 3) * 72 + r] = f2bf(hi16(v.y) * be);
    sVT[(c + 4) * 72 + r] = f2bf(lo16(v.z) * be); sVT[(c + 5) * 72 + r] = f2bf(hi16(v.z) * be);
    sVT[(c + 6) * 72 + r] = f2bf(lo16(v.w) * be); sVT[(c + 7) * 72 + r] = f2bf(hi16(v.w) * be);
  }
  __syncthreads();
  float* sL = (float*)sQ;
  u16* sA = sK;
  u16* sT = sK + 64 * 64;
#pragma unroll
  for (int r = 0; r < 16; ++r) {
    const int i = 32 * bi + (r & 3) + 8 * (r >> 2) + 4 * h5, j = 32 * bj + fr;
    const float dec = (i >= j) ? __expf(sGc[i] - sGc[j]) : 0.f;
    sL[i * 68 + j] = (i > j) ? sBe[i] * kk[r] * dec : 0.f;
    sA[i * 64 + j] = f2bf((i >= j) ? scale * qk[r] * dec : 0.f);
  }
  __syncthreads();
  if (wid == 0) {
    float t[64];
#pragma unroll
    for (int i = 0; i < 64; ++i) {
      float s = (i == lane) ? 1.f : 0.f;
#pragma unroll
      for (int j = 0; j < i; ++j) s -= sL[i * 68 + j] * t[j];
      t[i] = s;
      sT[i * 72 + lane] = f2bf(s);
    }
  } else {
    for (int g = tid - 64; g < 1024; g += 192) {
      const int r = g >> 4, gg = g & 15;
      *(uint2*)(aout + r * 64 + 4 * permg(gg)) = *(const uint2*)(sA + r * 64 + 4 * gg);
    }
  }
  __syncthreads();
  f32x16 ua[2], wa[2];
#pragma unroll
  for (int mi = 0; mi < 2; ++mi)
#pragma unroll
    for (int r = 0; r < 16; ++r) { ua[mi][r] = 0.f; wa[mi][r] = 0.f; }
#pragma unroll
  for (int ks = 0; ks < 4; ++ks) {
    const bf16x8 bu = *(const bf16x8*)(sVT + (32 * wid + fr) * 72 + ks * 16 + fh);
    const bf16x8 bw = *(const bf16x8*)(sKT + (32 * wid + fr) * 72 + ks * 16 + fh);
#pragma unroll
    for (int mi = 0; mi < 2; ++mi) {
      const bf16x8 at = *(const bf16x8*)(sT + (32 * mi + fr) * 72 + ks * 16 + fh);
      ua[mi] = __builtin_amdgcn_mfma_f32_32x32x16_bf16(at, bu, ua[mi], 0, 0, 0);
      wa[mi] = __builtin_amdgcn_mfma_f32_32x32x16_bf16(at, bw, wa[mi], 0, 0, 0);
    }
  }
  u16* sWs = sQ;
  {
    const int dv = 32 * wid + fr;
    u16* ub = P + (row0 + h5 * 4 + wid) * PC + C_CV + h * 128 + fr * 4;
#pragma unroll
    for (int mi = 0; mi < 2; ++mi) {
#pragma unroll
      for (int q = 0; q < 4; ++q) {
        uint2 o; o.x = pack2(ua[mi][4 * q], ua[mi][4 * q + 1]); o.y = pack2(ua[mi][4 * q + 2], ua[mi][4 * q + 3]);
        *(uint2*)(ub + (long)((mi * 4 + q) * 8) * PC) = o;
      }
#pragma unroll
      for (int r = 0; r < 16; ++r) {
        const int i = 32 * mi + (r & 3) + 8 * (r >> 2) + 4 * h5;
        sWs[i * 136 + dv] = f2bf(wa[mi][r]);
      }
    }
  }
  __syncthreads();
#pragma unroll
  for (int i = 0; i < 8; ++i) {
    const int gi = tid + 256 * i, r = gi >> 5, g = gi & 31;
    *(uint2*)(P + (row0 + r) * PC + C_CK + h * 128 + 4 * permg(g)) = *(const uint2*)(sWs + r * 136 + 4 * g);
  }
}

__device__ __forceinline__ void gdn_scan_item(const Params& p, u16* P, int b, int h) {
  const int tid0 = tid_op();
  u16* sW = (u16*)smem_raw;
  u16* sQd = sW + 64 * 136;
  u16* sKd = sQd + 64 * 136;
  u16* sAa = sKd + 128 * 72;
  const u16* MB = (const u16*)(p.ws + OFF_M) + (long)((b * 4 + h) * 256) * 12288;
  const float* GL = (const float*)(p.ws + OFF_GL) + (b * 4 + h) * 256;
  f32x16 S[4];
#pragma unroll
  for (int kt = 0; kt < 4; ++kt)
#pragma unroll
    for (int r = 0; r < 16; ++r) S[kt][r] = 0.f;
  v4u rw[4], rq[4], rk[4], ra[2];
  v2u ru[8];
  float gl_next;
#define GDN_ISSUE_A(NN)                                                                               \
  {                                                                                                   \
    const long row0_ = (long)b * SEQ + (NN) * 64;                                                     \
    _Pragma("unroll") for (int i = 0; i < 4; ++i) {                                                   \
      const int ch = tid + 256 * i, r = ch >> 4, c = (ch & 15) * 8;                                   \
      const u16* src = P + (row0_ + r) * PC + h * 128 + c;                                            \
      rw[i] = *(const v4u*)(src + C_CK);                                                              \
      rq[i] = *(const v4u*)(src + C_CQ);                                                              \
    }                                                                                                 \
  }
#define GDN_ISSUE_B(NN)                                                                               \
  {                                                                                                   \
    const u16* mb = MB + (long)(NN) * 12288;                                                          \
    _Pragma("unroll") for (int i = 0; i < 4; ++i) rk[i] = *(const v4u*)(mb + (tid + 256 * i) * 8);    \
    _Pragma("unroll") for (int i = 0; i < 2; ++i) ra[i] = *(const v4u*)(mb + 8192 + (tid + 256 * i) * 8); \
  }
#define GDN_ISSUE_U(NN)                                                                               \
  {                                                                                                   \
    const u16* ub = P + ((long)b * SEQ + (NN) * 64 + h5 * 4 + wid) * PC + C_CV + h * 128 + fr * 4;     \
    _Pragma("unroll") for (int i = 0; i < 8; ++i) ru[i] = *(const v2u*)(ub + (long)(i * 8) * PC);     \
  }
  {
    const int tid = tid0, lane = tid & 63, wid = tid >> 6, fr = lane & 31, h5 = lane >> 5, dv = 32 * wid + fr;
    GDN_ISSUE_A(0);
    GDN_ISSUE_B(0);
    GDN_ISSUE_U(0);
    gl_next = GL[0];
  }
  for (int n = 0; n < 256; ++n) {
    const long row0 = (long)b * SEQ + n * 64;
    const int nn = (n + 1 < 256) ? n + 1 : 255;
    int tl_ = tid0;
    asm volatile("" : "+v"(tl_));
    const int tid = tl_, lane = tid & 63, wid = tid >> 6, fr = lane & 31, h5 = lane >> 5, fh = h5 * 8, dv = 32 * wid + fr;
    lds_barrier();
#pragma unroll
    for (int i = 0; i < 4; ++i) {
      const int ch = tid + 256 * i, r = ch >> 4, c = (ch & 15) * 8;
      *(v4u*)(sW + r * 136 + c) = rw[i];
      *(v4u*)(sQd + r * 136 + c) = rq[i];
      const int r2 = ch >> 3, c2 = (ch & 7) * 8;
      *(v4u*)(sKd + r2 * 72 + c2) = rk[i];
    }
#pragma unroll
    for (int i = 0; i < 2; ++i) {
      const int ch = tid + 256 * i, r2 = ch >> 3, c2 = (ch & 7) * 8;
      *(v4u*)(sAa + r2 * 72 + c2) = ra[i];
    }
    const float gl = gl_next;
    gl_next = GL[nn];
    lds_barrier();
    f32x16 vn[2];
#pragma unroll
    for (int mi = 0; mi < 2; ++mi)
#pragma unroll
      for (int r = 0; r < 16; ++r) vn[mi][r] = 0.f;
    {
      bf16x8 fa[2][2];
#pragma unroll
      for (int mi = 0; mi < 2; ++mi) fa[0][mi] = *(const bf16x8*)(sW + (32 * mi + fr) * 136 + fh);
      const long rown_ = (long)b * SEQ + nn * 64;
      const u16* mbn_ = MB + (long)nn * 12288;
#pragma unroll
      for (int it = 0; it < 8; ++it) {
        if (it + 1 < 8) {
#pragma unroll
          for (int mi = 0; mi < 2; ++mi) fa[(it + 1) & 1][mi] = *(const bf16x8*)(sW + (32 * mi + fr) * 136 + 16 * (it + 1) + fh);
        }
        if (it < 4) {
          const int ch = tid + 256 * it, r = ch >> 4, c = (ch & 15) * 8;
          const u16* src = P + (rown_ + r) * PC + h * 128 + c;
          rw[it] = *(const v4u*)(src + C_CK);
          rq[it] = *(const v4u*)(src + C_CQ);
        } else {
          rk[it - 4] = *(const v4u*)(mbn_ + (tid + 256 * (it - 4)) * 8);
          if (it < 6) ra[it - 4] = *(const v4u*)(mbn_ + 8192 + (tid + 256 * (it - 4)) * 8);
        }
        __builtin_amdgcn_sched_barrier(0);
        const bf16x8 sb = pack8(S[it >> 1], it & 1);
#pragma unroll
        for (int mi = 0; mi < 2; ++mi) vn[mi] = __builtin_amdgcn_mfma_f32_32x32x16_bf16(fa[it & 1][mi], sb, vn[mi], 0, 0, 0);
        __builtin_amdgcn_sched_barrier(0);
      }
    }
#pragma unroll
    for (int mi = 0; mi < 2; ++mi)
#pragma unroll
      for (int q = 0; q < 4; ++q) {
        const v2u u2 = ru[mi * 4 + q];
        vn[mi][4 * q + 0] = lo16(u2.x) - vn[mi][4 * q + 0];
        vn[mi][4 * q + 1] = hi16(u2.x) - vn[mi][4 * q + 1];
        vn[mi][4 * q + 2] = lo16(u2.y) - vn[mi][4 * q + 2];
        vn[mi][4 * q + 3] = hi16(u2.y) - vn[mi][4 * q + 3];
      }
    bf16x8 vb[2][2];
#pragma unroll
    for (int mi = 0; mi < 2; ++mi)
#pragma unroll
      for (int s = 0; s < 2; ++s) vb[mi][s] = pack8(vn[mi], s);
    __builtin_amdgcn_sched_barrier(0);
    {
      f32x16 oo[2];
#pragma unroll
      for (int mi = 0; mi < 2; ++mi)
#pragma unroll
        for (int r = 0; r < 16; ++r) oo[mi][r] = 0.f;
      bf16x8 fa[2][2];
#pragma unroll
      for (int mi = 0; mi < 2; ++mi) fa[0][mi] = *(const bf16x8*)(sQd + (32 * mi + fr) * 136 + fh);
#pragma unroll
      for (int it = 0; it < 12; ++it) {
        if (it + 1 < 8) {
#pragma unroll
          for (int mi = 0; mi < 2; ++mi) fa[(it + 1) & 1][mi] = *(const bf16x8*)(sQd + (32 * mi + fr) * 136 + 16 * (it + 1) + fh);
        } else if (it + 1 < 12) {
          const int j = it + 1 - 8;
#pragma unroll
          for (int s = 0; s < 2; ++s) fa[(it + 1) & 1][s] = *(const bf16x8*)(sAa + (32 * (j >> 1) + fr) * 72 + 32 * (j & 1) + 16 * s + fh);
        }
        __builtin_amdgcn_sched_barrier(0);
        if (it < 8) {
          const bf16x8 sb = pack8(S[it >> 1], it & 1);
#pragma unroll
          for (int mi = 0; mi < 2; ++mi) oo[mi] = __builtin_amdgcn_mfma_f32_32x32x16_bf16(fa[it & 1][mi], sb, oo[mi], 0, 0, 0);
        } else {
          const int j = it - 8;
#pragma unroll
          for (int s = 0; s < 2; ++s) oo[j >> 1] = __builtin_amdgcn_mfma_f32_32x32x16_bf16(fa[it & 1][s], vb[j & 1][s], oo[j >> 1], 0, 0, 0);
        }
        __builtin_amdgcn_sched_barrier(0);
      }
      u16* ob = P + (row0 + h5 * 4 + wid) * PC + C_CV + h * 128 + fr * 4;
#pragma unroll
      for (int mi = 0; mi < 2; ++mi)
#pragma unroll
        for (int q = 0; q < 4; ++q) {
          uint2 o; o.x = pack2(oo[mi][4 * q], oo[mi][4 * q + 1]); o.y = pack2(oo[mi][4 * q + 2], oo[mi][4 * q + 3]);
          *(uint2*)(ob + (long)((mi * 4 + q) * 8) * PC) = o;
        }
    }
    __builtin_amdgcn_sched_barrier(0);
    {
      bf16x8 fa[2][2];
#pragma unroll
      for (int s = 0; s < 2; ++s) fa[0][s] = *(const bf16x8*)(sKd + fr * 72 + 16 * s + fh);
#pragma unroll
      for (int it = 0; it < 8; ++it) {
        if (it + 1 < 8) {
#pragma unroll
          for (int s = 0; s < 2; ++s)
            fa[(it + 1) & 1][s] = *(const bf16x8*)(sKd + (32 * ((it + 1) >> 1) + fr) * 72 + 32 * ((it + 1) & 1) + 16 * s + fh);
        }
        __builtin_amdgcn_sched_barrier(0);
        if ((it & 1) == 0) {
#pragma unroll
          for (int r = 0; r < 16; ++r) S[it >> 1][r] *= gl;
        }
#pragma unroll
        for (int s = 0; s < 2; ++s) S[it >> 1] = __builtin_amdgcn_mfma_f32_32x32x16_bf16(fa[it & 1][s], vb[it & 1][s], S[it >> 1], 0, 0, 0);
        __builtin_amdgcn_sched_barrier(0);
      }
    }
    GDN_ISSUE_U(nn);
  }
#undef GDN_ISSUE_A
#undef GDN_ISSUE_B
#undef GDN_ISSUE_U
}

__device__ __forceinline__ void gdn_post_item(const Params& p, int layer, u16* P, int b, int h, int n) {
  const int tid = tid_op();
  u16* sO = (u16*)smem_raw;
  const long row0 = (long)b * SEQ + n * 64;
  const float* gnp = p.gdn_norm + layer * 128;
  __syncthreads();
#pragma unroll
  for (int i = 0; i < 4; ++i) {
    const int ch = tid + 256 * i, r2 = ch >> 4, c = (ch & 15) * 8;
    const uint4 v = *(const uint4*)(P + (row0 + r2) * PC + C_CV + h * 128 + c);
    const int g = r2 >> 2, dvv = 32 * (r2 & 3) + (c >> 2);
    const int tok = 32 * (g >> 3) + 8 * ((g >> 1) & 3) + 4 * (g & 1);
    sO[(tok + 0) * 136 + dvv] = (u16)(v.x & 0xffffu); sO[(tok + 1) * 136 + dvv] = (u16)(v.x >> 16);
    sO[(tok + 2) * 136 + dvv] = (u16)(v.y & 0xffffu); sO[(tok + 3) * 136 + dvv] = (u16)(v.y >> 16);
    sO[(tok + 0) * 136 + dvv + 1] = (u16)(v.z & 0xffffu); sO[(tok + 1) * 136 + dvv + 1] = (u16)(v.z >> 16);
    sO[(tok + 2) * 136 + dvv + 1] = (u16)(v.w & 0xffffu); sO[(tok + 3) * 136 + dvv + 1] = (u16)(v.w >> 16);
  }
  __syncthreads();
  const int r = tid >> 2, cq = (tid & 3) * 32;
  float ss = 0.f;
#pragma unroll
  for (int i = 0; i < 4; ++i) {
    const uint4 v = *(const uint4*)(sO + r * 136 + cq + 8 * i);
    ss += lo16(v.x) * lo16(v.x) + hi16(v.x) * hi16(v.x) + lo16(v.y) * lo16(v.y) + hi16(v.y) * hi16(v.y) +
          lo16(v.z) * lo16(v.z) + hi16(v.z) * hi16(v.z) + lo16(v.w) * lo16(v.w) + hi16(v.w) * hi16(v.w);
  }
  ss += __shfl_xor(ss, 1);
  ss += __shfl_xor(ss, 2);
  const float rs = rsqrtf(ss * (1.f / 128.f) + 1e-6f);
  u16* zp = P + (row0 + r) * PC + C_CZ + h * 128 + cq;
#pragma unroll
  for (int i = 0; i < 4; ++i) {
    const uint4 zz = *(const uint4*)(zp + 8 * i);
    const uint4 vv = *(const uint4*)(sO + r * 136 + cq + 8 * i);
    const float ov[8] = {lo16(vv.x), hi16(vv.x), lo16(vv.y), hi16(vv.y), lo16(vv.z), hi16(vv.z), lo16(vv.w), hi16(vv.w)};
    const float4 g0 = *(const float4*)(gnp + cq + 8 * i);
    const float4 g1 = *(const float4*)(gnp + cq + 8 * i + 4);
    const float z[8] = {lo16(zz.x), hi16(zz.x), lo16(zz.y), hi16(zz.y), lo16(zz.z), hi16(zz.z), lo16(zz.w), hi16(zz.w)};
    const float gg[8] = {g0.x, g0.y, g0.z, g0.w, g1.x, g1.y, g1.z, g1.w};
    float y[8];
#pragma unroll
    for (int e = 0; e < 8; ++e) y[e] = ov[e] * rs * gg[e] * (z[e] * sigmoidf_(z[e]));
    uint4 o; o.x = pack2(y[0], y[1]); o.y = pack2(y[2], y[3]); o.z = pack2(y[4], y[5]); o.w = pack2(y[6], y[7]);
    *(uint4*)(zp + 8 * i) = o;
  }
}

__device__ __forceinline__ void phase_mixers(const Params& p, int layer, int part) {
  u16* P = (u16*)(p.ws + OFF_R);
  __shared__ int s_item;
  if (part == 0) {
    unsigned* cnt = (unsigned*)(p.ws + OFF_CNT) + layer;
    for (;;) {
      __syncthreads();
      if (tid_op() == 0) s_item = (int)atomicAdd(cnt, 1u);
      __syncthreads();
      const int it = s_item;
      if (it >= 6144) break;
      if (it < 2048) {
        gdn_prep_item(p, P, it >> 10, (it >> 8) & 3, it & 255);
      } else if (it < 4096) {
        const int k = it - 2048;
        const int qb = 127 - (k >> 4), bh = k & 15;
        sb_item(P, bh >> 3, bh & 7, qb);
      } else {
        const int k = it - 4096;
        swa_item(p, layer, P, k >> 10, (k >> 3) & 127, k & 7);
      }
    }
  } else {
    if (bid_op() < 8) gdn_scan_item(p, P, bid_op() >> 2, bid_op() & 3);
    const int xcd = bid_op() & 7;
    unsigned* cnt = (unsigned*)(p.ws + OFF_CNT) + 8 + layer * 8 + xcd;
    const int nb_ = bid_op() - (int)(gridDim.x >> 1);
    if (gridDim.x > 256 && nb_ >= 0 && nb_ < 8) return;
    for (;;) {
      __syncthreads();
      if (tid_op() == 0) s_item = (int)atomicAdd(cnt, 1u);
      __syncthreads();
      const int idx = s_item;
      if (idx >= 512) break;
      const int L = (((idx >> 6) << 3) + xcd) * 64 + (idx & 63);
      int m, nq;
      tile_mn(L, 256, 16, m, nq);
      merge_tile(p, m, nq, 1);
    }
  }
}

__device__ __forceinline__ void phase_gdn_post(const Params& p, int layer) {
  u16* P = (u16*)(p.ws + OFF_R);
  for (int it = bid_op(); it < 2048; it += gridDim.x) gdn_post_item(p, layer, P, it >> 10, (it >> 8) & 3, it & 255);
}

__device__ __forceinline__ void phase_prep(const Params& p) {
  if (bid_op() == 0 && tid_op() < 32) ((unsigned*)(p.ws + OFF_CNT))[tid_op()] = 0u;
  for (int j = bid_op(); j < 4608; j += gridDim.x) transpose_job(p, j);
  rownorm_phase(p, 0, nullptr, nullptr, p.ln_mix_pre, 0);
}

constexpr int N_PHASES = 1 + 10 * DEPTH;

__global__ void __launch_bounds__(256, 2) mega(Params p, int ph_lo, int ph_hi) {
  cg::grid_group grid = cg::this_grid();
  int ph = 0;
#define STEP(CALL)                                   \
  {                                                  \
    if (ph >= ph_lo && ph < ph_hi) {                 \
      if (ph > ph_lo) grid.sync();                   \
      CALL;                                          \
    }                                                \
    ++ph;                                            \
  }
  STEP(phase_prep(p));
#pragma unroll 1
  for (int layer = 0; layer < DEPTH; ++layer) {
    const u16* WL = (const u16*)(p.ws + OFF_WT);
    STEP(phase_inproj(p, layer));
    STEP(phase_mixers(p, layer, 0));
    STEP(phase_mixers(p, layer, 1));
    STEP(phase_gdn_post(p, layer));
    STEP(phase_merge(p, layer));
    STEP(phase_gemm_f32((const u16*)(p.ws + OFF_M), DM, WL + W_OUT, DM, (u16*)(p.ws + OFF_OUTF)));
    STEP(rownorm_phase(p, 1, (const u16*)(p.ws + OFF_OUTF), p.ln_mix_post + layer * DM, p.ln_ffn_pre + layer * DM, -1));
    STEP(phase_up(p, layer));
    STEP(phase_gemm_f32((const u16*)(p.ws + OFF_ACT), DFF, WL + W_DOWN, DFF, (u16*)(p.ws + OFF_OUTF2)));
    if (layer + 1 < DEPTH) {
      STEP(for (int j = bid_op(); j < 4608; j += gridDim.x) transpose_job(p, (layer + 1) * 4608 + j);
           rownorm_phase(p, 1, (const u16*)(p.ws + OFF_OUTF2), p.ln_ffn_post + layer * DM, p.ln_mix_pre + (layer + 1) * DM, layer + 1));
    } else {
      STEP(rownorm_phase(p, 1, (const u16*)(p.ws + OFF_OUTF2), p.ln_ffn_post + layer * DM, nullptr, -1));
    }
  }
#undef STEP
}

extern "C" void kernel_launch(void* const* d_in, const int* in_sizes, int n_in, void* d_out, int out_size, void* d_ws,
                              size_t ws_size, hipStream_t stream) {
  (void)in_sizes; (void)n_in; (void)out_size;
  if (ws_size < WS_NEED) { fprintf(stderr, "workspace too small: %zu < %zu\n", ws_size, (size_t)WS_NEED); return; }
  Params p{};
  p.x = (const float*)d_in[0]; p.ln_mix_pre = (const float*)d_in[1]; p.w_in = (const float*)d_in[2];
  p.sw_sinks = (const float*)d_in[3]; p.gdn_conv = (const float*)d_in[4]; p.gdn_a_log = (const float*)d_in[5];
  p.gdn_dt_bias = (const float*)d_in[6]; p.gdn_norm = (const float*)d_in[7]; p.w_br[0] = (const float*)d_in[8];
  p.w_br[1] = (const float*)d_in[9]; p.w_br[2] = (const float*)d_in[10]; p.w_out = (const float*)d_in[11];
  p.ln_mix_post = (const float*)d_in[12]; p.ln_ffn_pre = (const float*)d_in[13]; p.w_up = (const float*)d_in[14];
  p.ffn_conv = (const float*)d_in[15]; p.w_down = (const float*)d_in[16]; p.ln_ffn_post = (const float*)d_in[17];
  p.out = (float*)d_out; p.ws = (unsigned char*)d_ws;
  static int grid_blocks = 0;
  if (!grid_blocks) {
    int dev = 0, cus = 0, per_cu = 0;
    hipGetDevice(&dev);
    hipDeviceGetAttribute(&cus, hipDeviceAttributeMultiprocessorCount, dev);
    hipOccupancyMaxActiveBlocksPerMultiprocessor(&per_cu, mega, 256, 0);
    if (per_cu < 1) per_cu = 1;
    if (per_cu > 2) per_cu = 2;
    grid_blocks = cus * per_cu;
  }
#if MULTI_LAUNCH
  for (int ph = 0; ph < N_PHASES; ++ph) {
    int lo = ph, hi = ph + 1;
    void* args[] = {&p, &lo, &hi};
    hipError_t e = hipLaunchCooperativeKernel((void*)mega, dim3(grid_blocks), dim3(256), args, 0, stream);
    if (e != hipSuccess) fprintf(stderr, "launch failed: %s (grid %d)\n", hipGetErrorString(e), grid_blocks);
  }
#else
  int lo = 0, hi = N_PHASES;
  void* args[] = {&p, &lo, &hi};
  hipError_t e = hipLaunchCooperativeKernel((void*)mega, dim3(grid_blocks), dim3(256), args, 0, stream);
  if (e != hipSuccess) fprintf(stderr, "cooperative launch failed: %s (grid %d)\n", hipGetErrorString(e), grid_blocks);
#endif
}
```
